# Optimizing an MI355X kernel written in HIP

```python
import math
import jax, jax.numpy as jnp
from jax import lax
import numpy as np

D_MODEL = 4096
BATCH = 2
SEQ = 8192
DEPTH = 1

A_HEADS = 32
A_KV_HEADS = 4
A_HEAD_DIM = 64
A_WINDOW = 128
B_HEADS = 16
B_KV_GROUPS = 2
B_HEAD_DIM = 128
CMP_BLOCK = 32
CMP_STRIDE = 16
CMP_HIDDEN = 128
SLC_BLOCK = 64
N_SELECT = 16
B_WINDOW = 512
BAND_BLOCK = 128
SLC_QBLOCK = 64
D_FF = 11008
PLE_DIM = 256
ROPE_THETA = 10000.0
EPS = 1e-6

COLS = [
    A_HEADS * A_HEAD_DIM,
    A_KV_HEADS * A_HEAD_DIM,
    A_KV_HEADS * A_HEAD_DIM,
    B_HEADS * B_HEAD_DIM,
    B_KV_GROUPS * B_HEAD_DIM,
    B_KV_GROUPS * B_HEAD_DIM,
    B_KV_GROUPS * B_HEAD_DIM,
    B_KV_GROUPS * B_HEAD_DIM,
    B_KV_GROUPS * B_HEAD_DIM,
    B_KV_GROUPS * B_HEAD_DIM,
    B_HEADS * 3,
    D_MODEL,
    D_MODEL,
]
D_IN = sum(COLS)
SPLITS = [int(c) for c in np.cumsum(COLS)[:-1]]

kernel_name = "hybrid_swa_sink_nsa_macaron_ple"


def rms_norm(x, g):
    xf = x.astype(jnp.float32)
    var = jnp.mean(xf * xf, axis=-1, keepdims=True)
    return (xf * lax.rsqrt(var + EPS) * g.astype(jnp.float32)).astype(x.dtype)


def swiglu(x, w_gate, w_up, w_down):
    return (jax.nn.silu(x @ w_gate) * (x @ w_up)) @ w_down


def rope(x, positions):
    d = x.shape[-1]
    inv = jnp.power(jnp.float32(ROPE_THETA), -jnp.arange(0, d, 2, dtype=jnp.float32) / d)
    ang = positions.astype(jnp.float32)[:, :, None] * inv
    cos = jnp.cos(ang)[:, :, None, :]
    sin = jnp.sin(ang)[:, :, None, :]
    xf = x.astype(jnp.float32)
    x1, x2 = xf[..., : d // 2], xf[..., d // 2:]
    return jnp.concatenate([x1 * cos - x2 * sin, x2 * cos + x1 * sin], axis=-1).astype(x.dtype)


def banded_attention(q, k, v, window, sinks=None):
    B, T, H, D = q.shape
    G = k.shape[2]
    R = H // G
    blk = BAND_BLOCK
    nb = T // blk
    P = -(-(window - 1) // blk)
    qb = q.reshape(B, nb, blk, G, R, D)
    pad = ((0, 0), (P * blk, 0), (0, 0), (0, 0))
    kb = jnp.pad(k, pad).reshape(B, nb + P, blk, G, D)
    vb = jnp.pad(v, pad).reshape(B, nb + P, blk, G, D)
    kw = jnp.concatenate([kb[:, i:i + nb] for i in range(P + 1)], axis=2)
    vw = jnp.concatenate([vb[:, i:i + nb] for i in range(P + 1)], axis=2)
    s = jnp.einsum('bnqgrd,bnkgd->bngrqk', qb, kw).astype(jnp.float32) * (D ** -0.5)
    kwin = (P + 1) * blk
    qpos = jnp.arange(blk)[:, None] + P * blk
    kpos = jnp.arange(kwin)[None, :]
    diff = qpos - kpos
    mask_rel = (diff >= 0) & (diff < window)
    mask_abs = (jnp.arange(nb)[:, None] * blk + kpos - P * blk) >= 0
    mask = mask_rel[None, :, :] & mask_abs[:, None, :]
    s = jnp.where(mask[None, :, None, None], s, -jnp.inf)
    if sinks is not None:
        sk = sinks.astype(jnp.float32).reshape(1, 1, G, R, 1, 1)
        m = jnp.maximum(jnp.max(s, axis=-1, keepdims=True), sk)
        e = jnp.exp(s - m)
        prob = e / (jnp.sum(e, axis=-1, keepdims=True) + jnp.exp(sk - m))
    else:
        prob = jax.nn.softmax(s, axis=-1)
    o = jnp.einsum('bngrqk,bnkgd->bnqgrd', prob.astype(v.dtype), vw)
    return o.reshape(B, T, H, D)


def compress(kv, pe, w1, w2):
    B, T, G, D = kv.shape
    nc = (T - CMP_BLOCK) // CMP_STRIDE + 1
    idx = jnp.arange(nc)[:, None] * CMP_STRIDE + jnp.arange(CMP_BLOCK)[None, :]
    blocks = kv[:, idx] + pe[None, None, :, None, :]
    flat = jnp.moveaxis(blocks, 3, 2).reshape(B, nc, G, CMP_BLOCK * D)
    return jax.nn.gelu(flat @ w1) @ w2


def selection_map(nc, ns):
    a, b = SLC_BLOCK // CMP_STRIDE, CMP_BLOCK // CMP_STRIDE
    j = np.arange(ns)[:, None, None]
    c = a * j - np.arange(a)[None, :, None] - np.arange(b)[None, None, :]
    jj = np.broadcast_to(j, c.shape)
    ok = (c >= 0) & (c < nc)
    mat = np.zeros((nc, ns), np.float32)
    np.add.at(mat, (c[ok], jj[ok]), 1.0)
    return jnp.asarray(mat)


def selected_attention(q, k, v, sel):
    B, T, H, D = q.shape
    G = k.shape[2]
    R = H // G
    n = sel.shape[-1]
    ns = T // SLC_BLOCK
    qbs = SLC_QBLOCK
    nqb = T // qbs
    kbt = k.reshape(B, ns, SLC_BLOCK, G, D).transpose(0, 3, 1, 2, 4)
    vbt = v.reshape(B, ns, SLC_BLOCK, G, D).transpose(0, 3, 1, 2, 4)
    bi = jnp.arange(B)[:, None, None, None]
    gi = jnp.arange(G)[None, :, None, None]
    q_blocks = q.reshape(B, nqb, qbs, G, R, D).transpose(1, 0, 2, 3, 4, 5)
    sel_blocks = sel.reshape(B, G, nqb, qbs, n).transpose(2, 0, 1, 3, 4)
    starts = jnp.arange(nqb, dtype=jnp.int32) * qbs
    scale = D ** -0.5

    def one_block(args):
        qblk, sblk, t0 = args
        kg = kbt[bi, gi, sblk]
        vg = vbt[bi, gi, sblk]
        s = jnp.einsum('bqgrd,bgqnld->bgrqnl', qblk, kg).astype(jnp.float32) * scale
        kpos = sblk[..., None] * SLC_BLOCK + jnp.arange(SLC_BLOCK)
        tpos = t0 + jnp.arange(qbs)
        mask = kpos <= tpos[None, None, :, None, None]
        s = jnp.where(mask[:, :, None], s, -jnp.inf)
        prob = jax.nn.softmax(s.reshape(B, G, R, qbs, n * SLC_BLOCK), axis=-1).reshape(s.shape)
        return jnp.einsum('bgrqnl,bgqnld->bqgrd', prob.astype(v.dtype), vg)

    o = lax.map(one_block, (q_blocks, sel_blocks, starts))
    return o.transpose(1, 0, 2, 3, 4, 5).reshape(B, T, H, D)


def nsa_attention(q, kc, vc, ks, vs, kw, vw, gates, positions,
                  pe_k, w_ck1, w_ck2, pe_v, w_cv1, w_cv2):
    B, T, H, D = q.shape
    G = kc.shape[2]
    R = H // G
    scale = D ** -0.5
    kcmp = compress(kc, pe_k, w_ck1, w_ck2)
    vcmp = compress(vc, pe_v, w_cv1, w_cv2)
    nc = kcmp.shape[1]
    qg = q.reshape(B, T, G, R, D)
    s = jnp.einsum('btgrd,bcgd->bgrtc', qg, kcmp).astype(jnp.float32) * scale
    t_idx = jnp.arange(T)
    visible = (jnp.arange(nc) * CMP_STRIDE + CMP_BLOCK - 1)[None, :] <= t_idx[:, None]
    s = jnp.where(visible, s, -jnp.inf)
    m = jnp.max(s, axis=-1, keepdims=True)
    m = jnp.where(jnp.isfinite(m), m, 0.0)
    e = jnp.exp(s - m)
    den = jnp.sum(e, axis=-1, keepdims=True)
    p_cmp = e / jnp.where(den > 0, den, 1.0)
    o_cmp = jnp.einsum('bgrtc,bcgd->btgrd', p_cmp.astype(vcmp.dtype), vcmp).reshape(B, T, H, D)
    ns = T // SLC_BLOCK
    n_sel = min(N_SELECT, ns)
    imp = jnp.einsum('bgrtc,cj->bgtj', p_cmp, selection_map(nc, ns))
    j = jnp.arange(ns)[None, :]
    cur = (t_idx // SLC_BLOCK)[:, None]
    valid = j * SLC_BLOCK <= t_idx[:, None]
    forced = (j == 0) | (j == cur) | (j == cur - 1)
    score = jnp.where(forced, jnp.inf, jnp.where(valid, imp, -jnp.inf))
    _, sel = lax.top_k(score, n_sel)
    qr = rope(q, positions)
    o_slc = selected_attention(qr, rope(ks, positions), vs, sel)
    o_win = banded_attention(qr, rope(kw, positions), vw, B_WINDOW)
    g = jax.nn.sigmoid(gates.astype(jnp.float32)).astype(q.dtype)
    return g[..., 0:1] * o_cmp + g[..., 1:2] * o_slc + g[..., 2:3] * o_win


def setup_inputs(seed: int = 0) -> dict:
    key = jax.random.key(seed)
    ks = jax.random.split(key, 32)

    def w(k, shape, fan_in):
        return jax.random.normal(k, shape, jnp.float32) * (fan_in ** -0.5)

    def gain(k, shape):
        return 1.0 + 0.02 * jax.random.normal(k, shape, jnp.float32)

    L = DEPTH
    x = jax.random.normal(ks[0], (BATCH, SEQ, D_MODEL), jnp.float32)
    p = jax.random.normal(ks[1], (DEPTH, BATCH, SEQ, PLE_DIM), jnp.float32)
    offs = jax.random.randint(ks[2], (BATCH, 1), 0, 4096, dtype=jnp.int32)
    positions = (jnp.arange(SEQ, dtype=jnp.int32)[None, :] + offs).astype(jnp.int32)
    return {
        "x": x,
        "p": p,
        "positions": positions,
        "ffn1_norm": gain(ks[3], (L, D_MODEL)),
        "ffn1_w_gate": w(ks[4], (L, D_MODEL, D_FF), D_MODEL),
        "ffn1_w_up": w(ks[5], (L, D_MODEL, D_FF), D_MODEL),
        "ffn1_w_down": w(ks[6], (L, D_FF, D_MODEL), D_FF),
        "mix_norm": gain(ks[7], (L, D_MODEL)),
        "w_in": w(ks[8], (L, D_MODEL, D_IN), D_MODEL),
        "sinks": jax.random.normal(ks[9], (L, A_HEADS), jnp.float32),
        "nsa_pe_k": 0.1 * jax.random.normal(ks[10], (L, CMP_BLOCK, B_HEAD_DIM), jnp.float32),
        "nsa_w_ck1": w(ks[11], (L, CMP_BLOCK * B_HEAD_DIM, CMP_HIDDEN), CMP_BLOCK * B_HEAD_DIM),
        "nsa_w_ck2": w(ks[12], (L, CMP_HIDDEN, B_HEAD_DIM), CMP_HIDDEN),
        "nsa_pe_v": 0.1 * jax.random.normal(ks[13], (L, CMP_BLOCK, B_HEAD_DIM), jnp.float32),
        "nsa_w_cv1": w(ks[14], (L, CMP_BLOCK * B_HEAD_DIM, CMP_HIDDEN), CMP_BLOCK * B_HEAD_DIM),
        "nsa_w_cv2": w(ks[15], (L, CMP_HIDDEN, B_HEAD_DIM), CMP_HIDDEN),
        "w_o_a": w(ks[16], (L, A_HEADS * A_HEAD_DIM, D_MODEL), A_HEADS * A_HEAD_DIM),
        "w_o_b": w(ks[17], (L, B_HEADS * B_HEAD_DIM, D_MODEL), B_HEADS * B_HEAD_DIM),
        "w_o": w(ks[18], (L, D_MODEL, D_MODEL), D_MODEL),
        "ffn2_norm": gain(ks[19], (L, D_MODEL)),
        "ffn2_w_gate": w(ks[20], (L, D_MODEL, D_FF), D_MODEL),
        "ffn2_w_up": w(ks[21], (L, D_MODEL, D_FF), D_MODEL),
        "ffn2_w_down": w(ks[22], (L, D_FF, D_MODEL), D_FF),
        "ple_norm": gain(ks[23], (L, D_MODEL)),
        "w_ple_gate": w(ks[24], (L, D_MODEL, D_MODEL), D_MODEL),
        "w_ple_proj": w(ks[25], (L, PLE_DIM, D_MODEL), PLE_DIM),
        "final_norm": gain(ks[26], (D_MODEL,)),
    }


def reference(x, p, positions, ffn1_norm, ffn1_w_gate, ffn1_w_up, ffn1_w_down,
              mix_norm, w_in, sinks, nsa_pe_k, nsa_w_ck1, nsa_w_ck2,
              nsa_pe_v, nsa_w_cv1, nsa_w_cv2, w_o_a, w_o_b, w_o,
              ffn2_norm, ffn2_w_gate, ffn2_w_up, ffn2_w_down,
              ple_norm, w_ple_gate, w_ple_proj, final_norm):
    B, T, _ = x.shape
    h = x
    for i in range(DEPTH):
        h = h + 0.5 * swiglu(rms_norm(h, ffn1_norm[i]), ffn1_w_gate[i], ffn1_w_up[i], ffn1_w_down[i])
        u = rms_norm(h, mix_norm[i])
        (qa, ka, va, qb, kc, vc, ksl, vsl, kwn, vwn, gb, gate_a, gate_b) = jnp.split(
            u @ w_in[i], SPLITS, axis=-1)
        qa = rope(qa.reshape(B, T, A_HEADS, A_HEAD_DIM), positions)
        ka = rope(ka.reshape(B, T, A_KV_HEADS, A_HEAD_DIM), positions)
        va = va.reshape(B, T, A_KV_HEADS, A_HEAD_DIM)
        o_a = banded_attention(qa, ka, va, A_WINDOW, sinks[i])
        kv_shape = (B, T, B_KV_GROUPS, B_HEAD_DIM)
        o_b = nsa_attention(
            qb.reshape(B, T, B_HEADS, B_HEAD_DIM),
            kc.reshape(kv_shape), vc.reshape(kv_shape),
            ksl.reshape(kv_shape), vsl.reshape(kv_shape),
            kwn.reshape(kv_shape), vwn.reshape(kv_shape),
            gb.reshape(B, T, B_HEADS, 3), positions,
            nsa_pe_k[i], nsa_w_ck1[i], nsa_w_ck2[i], nsa_pe_v[i], nsa_w_cv1[i], nsa_w_cv2[i])
        y_a = o_a.reshape(B, T, -1) @ w_o_a[i]
        y_b = o_b.reshape(B, T, -1) @ w_o_b[i]
        merged = jax.nn.sigmoid(gate_a) * y_a + jax.nn.sigmoid(gate_b) * y_b
        h = h + merged @ w_o[i]
        h = h + 0.5 * swiglu(rms_norm(h, ffn2_norm[i]), ffn2_w_gate[i], ffn2_w_up[i], ffn2_w_down[i])
        ple_gate = jax.nn.sigmoid(rms_norm(h, ple_norm[i]) @ w_ple_gate[i])
        h = h + (p[i] @ w_ple_proj[i]) * ple_gate
    return rms_norm(h, final_norm)
```

```cpp
#include <hip/hip_runtime.h>
#include <stdio.h>
#include <stdint.h>

#ifndef MK_DBG
#define MK_DBG 0
#endif
#ifndef MK_DBG2
#define MK_DBG2 0
#endif
#ifndef MK_SKIP
#define MK_SKIP 0
#endif
#ifndef MK_P6CRIP
#define MK_P6CRIP 0
#endif
#ifndef MK_DUP
#define MK_DUP 0
#endif
#ifndef MK_PERMCHK
#define MK_PERMCHK 0
#endif
#ifndef MK_ONE_LAUNCH
#define MK_ONE_LAUNCH 1
#endif

#define GAS __attribute__((address_space(1)))
#define LAS __attribute__((address_space(3)))
typedef unsigned short bf16;
typedef short bf16x8 __attribute__((ext_vector_type(8)));
typedef float f32x4 __attribute__((ext_vector_type(4)));
typedef float f32x2 __attribute__((ext_vector_type(2)));
typedef unsigned u32x4 __attribute__((ext_vector_type(4)));
typedef unsigned u32x2 __attribute__((ext_vector_type(2)));

constexpr int BATCH = 2, T = 8192, M = BATCH * T, DM = 4096, DFF = 11008, PLE = 256;
constexpr int AH = 32, AKV = 4, AD = 64, AWIN = 128;
constexpr int BH = 16, BG = 2, BD = 128, BWIN = 512;
constexpr int NC = 511, NCP = 512, NS = 128, NSEL = 16;
constexpr int DIN = 14384, DIN_S = 14336;
constexpr float EPS = 1e-6f;
constexpr float LOG2E = 1.4426950408889634f;
constexpr int NWAVES = 8;
constexpr int NPHASE = 15;

constexpr size_t al256(size_t x) { return (x + 255) & ~(size_t)255; }
constexpr size_t WS_CTL = 0, CTL_BYTES = 1u << 20;
constexpr size_t WS_ROPE64 = WS_CTL + CTL_BYTES;
constexpr size_t WS_ROPE128 = WS_ROPE64 + (size_t)M * 32 * 8;
constexpr size_t WS_CBP = WS_ROPE128 + (size_t)M * 64 * 8;
constexpr size_t WS_WFF = al256(WS_CBP + 2 * 16 * 128 * 4);
constexpr size_t WS_WFD = WS_WFF + (size_t)2 * DFF * DM * 2;
constexpr size_t WS_WIN = WS_WFD + (size_t)DM * DFF * 2;
constexpr size_t WS_WG = WS_WIN + (size_t)DIN_S * DM * 2;
constexpr size_t WS_WOA = al256(WS_WG + (size_t)48 * DM * 2);
constexpr size_t WS_WOB = WS_WOA + (size_t)DM * 2048 * 2;
constexpr size_t WS_WO = WS_WOB + (size_t)DM * 2048 * 2;
constexpr size_t WS_WPG = WS_WO + (size_t)DM * DM * 2;
constexpr size_t WS_WPP = WS_WPG + (size_t)DM * DM * 2;
constexpr size_t WS_CK1 = WS_WPP + (size_t)DM * PLE * 2;
constexpr size_t WS_CV1 = WS_CK1 + (size_t)128 * 4096 * 2;
constexpr size_t WS_CK2 = WS_CV1 + (size_t)128 * 4096 * 2;
constexpr size_t WS_CV2 = WS_CK2 + (size_t)128 * 128 * 2;
constexpr size_t WS_P16 = WS_CV2 + (size_t)128 * 128 * 2;
constexpr size_t WS_XN = WS_P16 + (size_t)M * PLE * 2;
constexpr size_t WS_SGA = WS_XN + (size_t)M * DM * 2;
constexpr size_t WS_SGB = WS_SGA + (size_t)M * DM * 2;
constexpr size_t WS_OA = WS_SGB + (size_t)M * DM * 2;
constexpr size_t WS_OB = WS_OA + (size_t)M * 2048 * 2;
constexpr size_t WS_ACT = WS_OB + (size_t)M * 2048 * 2;
constexpr size_t WS_QA = WS_ACT;
constexpr size_t WS_KA = WS_QA + (size_t)M * 2048 * 2;
constexpr size_t WS_VAT = WS_KA + (size_t)M * 256 * 2;
constexpr size_t WS_QB0 = WS_VAT + (size_t)M * 256 * 2;
constexpr size_t WS_QBR = WS_QB0 + (size_t)M * 2048 * 2;
constexpr size_t WS_KC = WS_QBR + (size_t)M * 2048 * 2;
constexpr size_t WS_VC = WS_KC + (size_t)M * 256 * 2;
constexpr size_t WS_KS = WS_VC + (size_t)M * 256 * 2;
constexpr size_t WS_VST = WS_KS + (size_t)M * 256 * 2;
constexpr size_t WS_KW = WS_VST + (size_t)M * 256 * 2;
constexpr size_t WS_VWT = WS_KW + (size_t)M * 256 * 2;
constexpr size_t WS_KCMP = WS_VWT + (size_t)M * 256 * 2;
constexpr size_t WS_VCMPT = WS_KCMP + (size_t)4 * NCP * 128 * 2;
constexpr size_t WS_SGN = WS_VCMPT + (size_t)4 * NCP * 128 * 2;
constexpr size_t WS_QEND = WS_SGN + (size_t)M * 48 * 4;
constexpr size_t WS_PP = WS_SGA;
constexpr size_t WS_END = WS_ACT + (size_t)M * DFF * 2;
static_assert(WS_QEND <= WS_END && WS_PP + (size_t)M * DM * 4 <= WS_OA, "d_ws map");
constexpr int CW_BAR = 4096;
constexpr int CW_Q5 = 16384, CW_Q6 = 16384 + 64 * 8;

typedef __bf16 bf16x2_t __attribute__((ext_vector_type(2)));
__device__ __forceinline__ unsigned cvt_pk_bf16(float lo, float hi) { f32x2 v = {lo, hi}; bf16x2_t b = __builtin_convertvector(v, bf16x2_t); return __builtin_bit_cast(unsigned, b); }
__device__ __forceinline__ float bf_lo(unsigned w) { return __uint_as_float(w << 16); }
__device__ __forceinline__ float bf_hi(unsigned w) { return __uint_as_float(w & 0xffff0000u); }
__device__ __forceinline__ float fast_sigmoid(float x) { return __builtin_amdgcn_rcpf(1.0f + __builtin_amdgcn_exp2f(-x * LOG2E)); }
__device__ __forceinline__ float wave_sum(float v) {
#pragma unroll
    for (int o = 1; o < 64; o <<= 1) v += __shfl_xor(v, o);
    return v;
}
__device__ __forceinline__ float rows4_max(float x) {
    auto a = __builtin_amdgcn_permlane16_swap(__float_as_uint(x), __float_as_uint(x), false, false); x = fmaxf(__uint_as_float(a[0]), __uint_as_float(a[1]));
    auto b = __builtin_amdgcn_permlane32_swap(__float_as_uint(x), __float_as_uint(x), false, false); return fmaxf(__uint_as_float(b[0]), __uint_as_float(b[1]));
}
__device__ __forceinline__ float rows4_sum(float x) {
    auto a = __builtin_amdgcn_permlane16_swap(__float_as_uint(x), __float_as_uint(x), false, false); x = __uint_as_float(a[0]) + __uint_as_float(a[1]);
    auto b = __builtin_amdgcn_permlane32_swap(__float_as_uint(x), __float_as_uint(x), false, false); return __uint_as_float(b[0]) + __uint_as_float(b[1]);
}
__device__ __forceinline__ unsigned half32_umax(unsigned v) {
    unsigned t;
    t = (unsigned)__builtin_amdgcn_update_dpp(0, (int)v, 0xB1, 0xF, 0xF, true); v = v > t ? v : t;
    t = (unsigned)__builtin_amdgcn_update_dpp(0, (int)v, 0x4E, 0xF, 0xF, true); v = v > t ? v : t;
    t = (unsigned)__builtin_amdgcn_update_dpp(0, (int)v, 0x141, 0xF, 0xF, true); v = v > t ? v : t;
    t = (unsigned)__builtin_amdgcn_update_dpp(0, (int)v, 0x140, 0xF, 0xF, true); v = v > t ? v : t;
    auto a = __builtin_amdgcn_permlane16_swap(v, v, false, false); return a[0] > a[1] ? a[0] : a[1];
}
__device__ __forceinline__ float heads8_sum(float v) {
    v += __int_as_float(__builtin_amdgcn_update_dpp(0, __float_as_int(v), 0xB1, 0xF, 0xF, true));
    v += __int_as_float(__builtin_amdgcn_update_dpp(0, __float_as_int(v), 0x4E, 0xF, 0xF, true));
    v += __int_as_float(__builtin_amdgcn_update_dpp(0, __float_as_int(v), 0x141, 0xF, 0xF, true));
    return v;
}
#define LDS_WAIT() asm volatile("s_waitcnt lgkmcnt(0)" ::: "memory")
#define VM_WAIT() asm volatile("s_waitcnt vmcnt(0)" ::: "memory")

namespace pg8 {
constexpr int BM = 256, BK = 64, HALF = 128, HTB = HALF * BK * 2, STAGE_BYTES = 8 * HTB, NXCD = 8, WGM = 8;
__host__ __device__ __forceinline__ int lds_byte(int r, int c) { const int st = (r >> 4) * 2 + (c >> 5), rr = r & 15, cc = c & 31, ob = rr * 64 + cc * 2; return st * 1024 + (ob ^ (((ob >> 9) & 1) << 5)); }
__host__ __device__ __forceinline__ void stage_rc(int b, int& R, int& C) { const int st = b / 1024, sb = b % 1024, swz = sb ^ (((sb >> 9) & 1) << 5); R = (st >> 1) * 16 + swz / 64; C = (st & 1) * 32 + (swz % 64) / 2; }
__host__ __device__ __forceinline__ int perm32(int rho) { const int n = rho >> 4, i = rho & 15; return 8 * (i >> 2) + 4 * n + (i & 3); }

struct Unit { int pm, pn, sub; };
struct Gemm { const bf16* A; const bf16* Bt; const bf16* A2; const bf16* Bt2; int K; int ablk; int bblk; };

struct StaticOrder {
    int nM, nN, nwg, G, c, wgm;
    __device__ void init(int Mr, int N, int G_, int c_, int wgm_ = WGM) { nM = Mr / BM; nN = N / BM; nwg = nM * nN; G = G_; c = c_; wgm = wgm_; }
    __device__ bool next(int i, Unit& u) const {
        const long L = (long)i * G + c; if (L >= nwg) return false;
        int wgid = (int)L; { const int q = nwg / NXCD, r = nwg % NXCD, xcd = wgid % NXCD, off = wgid / NXCD; wgid = (xcd < r ? xcd * (q + 1) : r * (q + 1) + (xcd - r) * q) + off; }
        const int nig = wgm * nN, gid = wgid / nig, fm = gid * wgm, gsz = (nM - fm) < wgm ? (nM - fm) : wgm;
        u.pm = fm + ((wgid % nig) % gsz); u.pn = (wgid % nig) / gsz; u.sub = 0; return true;
    }
};
struct PairOrder : StaticOrder {
    __device__ bool next(int i, Unit& u) const { const bool ok = StaticOrder::next(i >> 1, u); u.sub = i & 1; return ok; }
};

template <class Epi, class Sched>
__device__ __forceinline__ void gemm_phase(LAS unsigned char* lds, const Gemm g, const Sched& S, const Epi& E) {
    const int tid = threadIdx.x, wid = __builtin_amdgcn_readfirstlane(tid >> 6), lane = tid & 63, wr = wid >> 2, wc = wid & 3, fr = lane & 15, fq = lane >> 4;
    const int K = g.K, nt = K / BK;
    unsigned voffA[2], voffB[2];
#pragma unroll
    for (int i = 0; i < 2; ++i) { int R, C; stage_rc(tid * 16 + i * 8192, R, C); const int Rb = Epi::PERM ? ((R & ~31) + perm32(R & 31)) : R;
        voffA[i] = (unsigned)(R * (g.ablk ? BK : K) + C) * 2u; voffB[i] = (unsigned)(Rb * (g.bblk ? BK : K) + C) * 2u; }
    const size_t kstep = (size_t)(BK * 2);
    const size_t hstep = (size_t)HALF * K * 2;
    const size_t tstep = 2 * hstep;
    const size_t kstepA = g.ablk ? (size_t)BM * BK * 2 : kstep, hstepA = g.ablk ? (size_t)HALF * BK * 2 : hstep, tstepA = g.ablk ? (size_t)nt * BM * BK * 2 : tstep;
    const size_t kstepB = g.bblk ? (size_t)BM * BK * 2 : kstep, hstepB = g.bblk ? (size_t)HALF * BK * 2 : hstep, tstepB = g.bblk ? (size_t)nt * BM * BK * 2 : tstep;
    const unsigned ldsw = (unsigned)wid * 1024u;
    const int aoff = lds_byte(wr * 64 + fr, fq * 8), boff = lds_byte(wc * 32 + fr, fq * 8);
#define PG8_SA(b, h) (((b) * 2 + (h)) * HTB)
#define PG8_SB(b, h) ((4 + (b) * 2 + (h)) * HTB)
#define PG8_STAGE(bufoff, gbase, voff) do { _Pragma("unroll") for (int _i = 0; _i < 2; ++_i) \
        __builtin_amdgcn_global_load_lds((const unsigned*)((const char*)(gbase) + (voff)[_i]), (LAS unsigned*)(lds + (bufoff) + ldsw + _i * 8192), 16, 0, 0); } while (0)
#define PG8_LDA(dst, b, h) do { _Pragma("unroll") for (int m = 0; m < 4; ++m) _Pragma("unroll") for (int k = 0; k < 2; ++k) dst[m][k] = *(const LAS bf16x8*)(lds + PG8_SA(b, h) + aoff + m * 2048 + k * 1024); } while (0)
#define PG8_LDB(dst, b, h) do { _Pragma("unroll") for (int n = 0; n < 2; ++n) _Pragma("unroll") for (int k = 0; k < 2; ++k) dst[n][k] = *(const LAS bf16x8*)(lds + PG8_SB(b, h) + boff + n * 2048 + k * 1024); } while (0)
#define PG8_MMA(ai, bj, At, Bt) do { __builtin_amdgcn_s_setprio(1); _Pragma("unroll") for (int m = 0; m < 4; ++m) _Pragma("unroll") for (int n = 0; n < 2; ++n) _Pragma("unroll") for (int k = 0; k < 2; ++k) \
        acc[ai][bj][m][n] = __builtin_amdgcn_mfma_f32_16x16x32_bf16(Bt[n][k], At[m][k], acc[ai][bj][m][n], 0, 0, 0); __builtin_amdgcn_s_setprio(0); } while (0)
#define PG8_WAIT_V(n) asm volatile("s_waitcnt vmcnt(" #n ")" ::: "memory")
#define PG8_WAIT_L(n) asm volatile("s_waitcnt lgkmcnt(" #n ")" ::: "memory")
#define PG8_BAR __builtin_amdgcn_s_barrier()
#define PG8_SCHED __builtin_amdgcn_sched_barrier(0)
    Unit cur, nxt; int ui = 0;
    if (!S.next(0, cur)) return;
    f32x4 acc[2][2][4][2];
#pragma unroll
    for (int a = 0; a < 2; ++a)
#pragma unroll
        for (int b = 0; b < 2; ++b)
#pragma unroll
            for (int m = 0; m < 4; ++m)
#pragma unroll
                for (int n = 0; n < 2; ++n) acc[a][b][m][n] = (f32x4){0.f, 0.f, 0.f, 0.f};
    bf16x8 At[4][2], B0[2][2], B1[2][2];
    const char* cA = (const char*)(cur.sub ? g.A2 : g.A) + (size_t)cur.pm * tstepA; const char* cB = (const char*)(cur.sub ? g.Bt2 : g.Bt) + (size_t)cur.pn * tstepB;
    PG8_STAGE(PG8_SB(0, 0), cB, voffB); PG8_STAGE(PG8_SB(0, 1), cB + hstepB, voffB); PG8_STAGE(PG8_SA(0, 0), cA, voffA); PG8_STAGE(PG8_SA(0, 1), cA + hstepA, voffA);
    if (wr == 1) PG8_BAR;
    PG8_WAIT_V(2); PG8_BAR;
    PG8_STAGE(PG8_SB(1, 0), cB + kstepB, voffB); PG8_STAGE(PG8_SA(1, 0), cA + kstepA, voffA); PG8_STAGE(PG8_SB(1, 1), cB + hstepB + kstepB, voffB);
    PG8_WAIT_V(6); PG8_BAR;
    for (;;) {
        const bool has_next = S.next(ui + 1, nxt);
        const char* nA = has_next ? (const char*)(nxt.sub ? g.A2 : g.A) + (size_t)nxt.pm * tstepA : cA; const char* nB = has_next ? (const char*)(nxt.sub ? g.Bt2 : g.Bt) + (size_t)nxt.pn * tstepB : cB;
        for (int t = 0; t < nt; t += 2) {
            const bool last = (t == nt - 2);
            const char* a1 = cA + (size_t)(t + 1) * kstepA;
            const char* a2 = last ? nA : cA + (size_t)(t + 2) * kstepA; const char* b2 = last ? nB : cB + (size_t)(t + 2) * kstepB;
            const char* a3 = a2 + kstepA; const char* b3 = b2 + kstepB;
            PG8_LDB(B0, 0, 0); PG8_LDB(B1, 0, 1); PG8_SCHED; PG8_LDA(At, 0, 0); PG8_STAGE(PG8_SA(1, 1), a1 + hstepA, voffA);
            PG8_WAIT_V(8); PG8_WAIT_L(0); PG8_BAR; PG8_MMA(0, 0, At, B0); PG8_MMA(0, 1, At, B1); PG8_BAR; PG8_SCHED;
            PG8_LDA(At, 0, 1); PG8_STAGE(PG8_SB(0, 0), b2, voffB); PG8_STAGE(PG8_SB(0, 1), b2 + hstepB, voffB); PG8_STAGE(PG8_SA(0, 0), a2, voffA);
            PG8_WAIT_V(8); PG8_WAIT_L(0); PG8_BAR; PG8_MMA(1, 0, At, B0); PG8_MMA(1, 1, At, B1); PG8_BAR; PG8_SCHED;
            PG8_LDB(B0, 1, 0); PG8_LDB(B1, 1, 1); PG8_SCHED; PG8_LDA(At, 1, 0); PG8_STAGE(PG8_SA(0, 1), a2 + hstepA, voffA);
            PG8_WAIT_V(8); PG8_WAIT_L(0); PG8_BAR; PG8_MMA(0, 0, At, B0); PG8_MMA(0, 1, At, B1); PG8_BAR; PG8_SCHED;
            PG8_LDA(At, 1, 1); PG8_STAGE(PG8_SB(1, 0), b3, voffB); PG8_STAGE(PG8_SB(1, 1), b3 + hstepB, voffB); PG8_STAGE(PG8_SA(1, 0), a3, voffA);
            PG8_WAIT_V(8); PG8_WAIT_L(0); PG8_BAR; PG8_MMA(1, 0, At, B0); PG8_MMA(1, 1, At, B1); PG8_BAR; PG8_SCHED;
        }
        if (wr == 0) PG8_BAR;
        E(acc, cur, wr, wc, fr, fq);
        if (!has_next) break;
#pragma unroll
        for (int a = 0; a < 2; ++a)
#pragma unroll
            for (int b = 0; b < 2; ++b)
#pragma unroll
                for (int m = 0; m < 4; ++m)
#pragma unroll
                    for (int n = 0; n < 2; ++n) acc[a][b][m][n] = (f32x4){0.f, 0.f, 0.f, 0.f};
        cur = nxt; cA = nA; cB = nB; ++ui;
        if (wr == 1) PG8_BAR;
    }
    PG8_WAIT_V(0);
    PG8_BAR;
#undef PG8_SA
#undef PG8_SB
#undef PG8_STAGE
#undef PG8_LDA
#undef PG8_LDB
#undef PG8_MMA
#undef PG8_WAIT_V
#undef PG8_WAIT_L
#undef PG8_BAR
#undef PG8_SCHED
}

struct EpiFF {
    static constexpr bool PERM = true;
    bf16* ACT;
    __device__ __forceinline__ void operator()(const f32x4 (&acc)[2][2][4][2], const Unit& u, int wr, int wc, int fr, int fq) const {
        const int row0 = u.pm * BM + wr * 64 + fr, col0 = u.pn * 128 + wc * 32 + 8 * fq;
#pragma unroll
        for (int ai = 0; ai < 2; ++ai)
#pragma unroll
            for (int m = 0; m < 4; ++m) {
                const f32x4 g0 = acc[ai][0][m][0], g1 = acc[ai][0][m][1], u0 = acc[ai][1][m][0], u1 = acc[ai][1][m][1];
                float a[8];
#pragma unroll
                for (int j = 0; j < 4; ++j) { a[j] = g0[j] * fast_sigmoid(g0[j]) * u0[j]; a[4 + j] = g1[j] * fast_sigmoid(g1[j]) * u1[j]; }
                u32x4 w; w.x = cvt_pk_bf16(a[0], a[1]); w.y = cvt_pk_bf16(a[2], a[3]); w.z = cvt_pk_bf16(a[4], a[5]); w.w = cvt_pk_bf16(a[6], a[7]);
                *(u32x4*)(ACT + (((size_t)u.pm * (DFF / 64) + (col0 >> 6)) * BM + (wr * 64 + fr + ai * HALF + m * 16)) * 64 + (col0 & 63)) = w;
            }
    }
};
struct EpiRes {
    static constexpr bool PERM = false;
    const float* resid; float* out; float scale;
    __device__ __forceinline__ void operator()(const f32x4 (&acc)[2][2][4][2], const Unit& u, int wr, int wc, int fr, int fq) const {
        int row0 = u.pm * BM + wr * 64 + fr; const int col0 = u.pn * BM + wc * 32 + 4 * fq;
        asm volatile("" : "+v"(row0));
#pragma unroll
        for (int ai = 0; ai < 2; ++ai)
#pragma unroll
            for (int mh = 0; mh < 2; ++mh) {
                f32x4 r[2][2][2];
#pragma unroll
                for (int m2 = 0; m2 < 2; ++m2) { const size_t off = (size_t)(row0 + ai * HALF + (2 * mh + m2) * 16) * DM + col0;
#pragma unroll
                    for (int bj = 0; bj < 2; ++bj)
#pragma unroll
                        for (int n = 0; n < 2; ++n) r[m2][bj][n] = *(const f32x4*)(resid + off + bj * HALF + n * 16); }
                asm volatile("" ::: "memory");
#pragma unroll
                for (int m2 = 0; m2 < 2; ++m2) { const size_t off = (size_t)(row0 + ai * HALF + (2 * mh + m2) * 16) * DM + col0;
#pragma unroll
                    for (int bj = 0; bj < 2; ++bj)
#pragma unroll
                        for (int n = 0; n < 2; ++n) *(f32x4*)(out + off + bj * HALF + n * 16) = r[m2][bj][n] + acc[ai][bj][2 * mh + m2][n] * scale; }
                asm volatile("" ::: "memory");
            }
    }
};
struct EpiF32 {
    static constexpr bool PERM = false;
    float* C;
    __device__ __forceinline__ void operator()(const f32x4 (&acc)[2][2][4][2], const Unit& u, int wr, int wc, int fr, int fq) const {
        const int row0 = u.pm * BM + wr * 64 + fr, col0 = u.pn * BM + wc * 32 + 4 * fq;
#pragma unroll
        for (int ai = 0; ai < 2; ++ai)
#pragma unroll
            for (int m = 0; m < 4; ++m) { float* rowp = C + (size_t)(row0 + ai * HALF + m * 16) * DM + col0;
#pragma unroll
                for (int bj = 0; bj < 2; ++bj)
#pragma unroll
                    for (int n = 0; n < 2; ++n) *(f32x4*)(rowp + bj * HALF + n * 16) = acc[ai][bj][m][n]; }
    }
};
struct EpiPle {
    static constexpr bool PERM = false;
    const float* PP; float* out;
    __device__ __forceinline__ void operator()(const f32x4 (&acc)[2][2][4][2], const Unit& u, int wr, int wc, int fr, int fq) const {
        int row0 = u.pm * BM + wr * 64 + fr; const int col0 = u.pn * BM + wc * 32 + 4 * fq;
        asm volatile("" : "+v"(row0));
#pragma unroll
        for (int ai = 0; ai < 2; ++ai)
#pragma unroll
            for (int mh = 0; mh < 2; ++mh) {
                f32x4 r[2][2][2], pp[2][2][2];
#pragma unroll
                for (int m2 = 0; m2 < 2; ++m2) { const size_t off = (size_t)(row0 + ai * HALF + (2 * mh + m2) * 16) * DM + col0;
#pragma unroll
                    for (int bj = 0; bj < 2; ++bj)
#pragma unroll
                        for (int n = 0; n < 2; ++n) { r[m2][bj][n] = *(const f32x4*)(out + off + bj * HALF + n * 16); pp[m2][bj][n] = *(const f32x4*)(PP + off + bj * HALF + n * 16); } }
                asm volatile("" ::: "memory");
#pragma unroll
                for (int m2 = 0; m2 < 2; ++m2) { const size_t off = (size_t)(row0 + ai * HALF + (2 * mh + m2) * 16) * DM + col0;
#pragma unroll
                    for (int bj = 0; bj < 2; ++bj)
#pragma unroll
                        for (int n = 0; n < 2; ++n) { const f32x4 a = acc[ai][bj][2 * mh + m2][n]; f32x4 sv_;
#pragma unroll
                            for (int j = 0; j < 4; ++j) sv_[j] = r[m2][bj][n][j] + pp[m2][bj][n][j] * fast_sigmoid(a[j]);
                            *(f32x4*)(out + off + bj * HALF + n * 16) = sv_; } }
                asm volatile("" ::: "memory");
            }
    }
};
struct EpiMerge {
    static constexpr bool PERM = true;
    const bf16* SGA; const bf16* SGB; bf16* MG;
    __device__ __forceinline__ void operator()(const f32x4 (&acc)[2][2][4][2], const Unit& u, int wr, int wc, int fr, int fq) const {
        int row0 = u.pm * BM + wr * 64 + fr; const int col0 = u.pn * BM + wc * 32 + 8 * fq;
        asm volatile("" : "+v"(row0));
        const bf16* SG = u.sub ? SGB : SGA;
#pragma unroll
        for (int ai = 0; ai < 2; ++ai) {
            u32x4 sg[4][2], pm_[4][2];
#pragma unroll
            for (int m = 0; m < 4; ++m)
#pragma unroll
                for (int bj = 0; bj < 2; ++bj) { const size_t o = (size_t)(row0 + ai * HALF + m * 16) * DM + col0 + bj * HALF; sg[m][bj] = *(const u32x4*)(SG + o); pm_[m][bj] = u.sub ? *(const u32x4*)(MG + o) : (u32x4){0u, 0u, 0u, 0u}; }
            asm volatile("" ::: "memory");
#pragma unroll
            for (int m = 0; m < 4; ++m)
#pragma unroll
                for (int bj = 0; bj < 2; ++bj) {
                    const size_t o = (size_t)(row0 + ai * HALF + m * 16) * DM + col0 + bj * HALF;
                    const u32x4 g_ = sg[m][bj], p = pm_[m][bj]; const f32x4 v0 = acc[ai][bj][m][0], v1 = acc[ai][bj][m][1];
                    const float r[8] = { v0[0] * bf_lo(g_.x) + bf_lo(p.x), v0[1] * bf_hi(g_.x) + bf_hi(p.x), v0[2] * bf_lo(g_.y) + bf_lo(p.y), v0[3] * bf_hi(g_.y) + bf_hi(p.y),
                                         v1[0] * bf_lo(g_.z) + bf_lo(p.z), v1[1] * bf_hi(g_.z) + bf_hi(p.z), v1[2] * bf_lo(g_.w) + bf_lo(p.w), v1[3] * bf_hi(g_.w) + bf_hi(p.w) };
                    u32x4 w; w.x = cvt_pk_bf16(r[0], r[1]); w.y = cvt_pk_bf16(r[2], r[3]); w.z = cvt_pk_bf16(r[4], r[5]); w.w = cvt_pk_bf16(r[6], r[7]);
                    *(u32x4*)(MG + o) = w;
                }
            asm volatile("" ::: "memory");
        }
    }
};
struct EpiIn {
    static constexpr bool PERM = true;
    unsigned char* ws;
    __device__ __forceinline__ static u32x4 pack8(const f32x4 a, const f32x4 b) { u32x4 w; w.x = cvt_pk_bf16(a[0], a[1]); w.y = cvt_pk_bf16(a[2], a[3]); w.z = cvt_pk_bf16(b[0], b[1]); w.w = cvt_pk_bf16(b[2], b[3]); return w; }
    __device__ __forceinline__ void operator()(const f32x4 (&acc)[2][2][4][2], const Unit& u, int wr, int wc, int fr, int fq) const {
        const int pn = u.pn, row0 = u.pm * BM + wr * 64 + fr;
        if (pn >= 24) {
            bf16* dst = (bf16*)(ws + (pn >= 40 ? WS_SGB : WS_SGA)); const int col0 = ((pn - 24) & 15) * 256 + wc * 32 + 8 * fq;
#pragma unroll
            for (int ai = 0; ai < 2; ++ai)
#pragma unroll
                for (int m = 0; m < 4; ++m)
#pragma unroll
                    for (int bj = 0; bj < 2; ++bj) { f32x4 a = acc[ai][bj][m][0], b = acc[ai][bj][m][1];
#pragma unroll
                        for (int j = 0; j < 4; ++j) { a[j] = fast_sigmoid(a[j]); b[j] = fast_sigmoid(b[j]); }
                        *(u32x4*)(dst + (size_t)(row0 + ai * HALF + m * 16) * DM + col0 + bj * HALF) = pack8(a, b); }
        } else if ((MK_SKIP & 1) && pn < 9) {
        } else if ((MK_SKIP & 2) && ((pn >= 10 && pn < 18) || pn == 20 || pn == 22)) {
        } else if ((MK_SKIP & 4) && (pn == 18 || pn == 19)) {
        } else if ((MK_SKIP & 8) && (pn == 9 || pn == 21 || pn == 23)) {
        } else if (pn < 9) {
            bf16* dst = (bf16*)(ws + (pn == 8 ? WS_KA : WS_QA)); const int ld = pn == 8 ? 256 : 2048; const int q = 4 * (wc & 1) + fq;
            const f32x4* rt = (const f32x4*)(ws + WS_ROPE64);
#pragma unroll
            for (int ai = 0; ai < 2; ++ai)
#pragma unroll
                for (int m = 0; m < 4; ++m) { const int row = row0 + ai * HALF + m * 16; const f32x4* rr = rt + (size_t)row * 16 + 2 * q; const f32x4 cs0 = rr[0], cs1 = rr[1];
#pragma unroll
                    for (int bj = 0; bj < 2; ++bj) { const f32x4 x1 = acc[ai][bj][m][0], x2 = acc[ai][bj][m][1]; f32x4 o1, o2;
                        o1[0] = x1[0] * cs0[0] - x2[0] * cs0[1]; o2[0] = x2[0] * cs0[0] + x1[0] * cs0[1];
                        o1[1] = x1[1] * cs0[2] - x2[1] * cs0[3]; o2[1] = x2[1] * cs0[2] + x1[1] * cs0[3];
                        o1[2] = x1[2] * cs1[0] - x2[2] * cs1[1]; o2[2] = x2[2] * cs1[0] + x1[2] * cs1[1];
                        o1[3] = x1[3] * cs1[2] - x2[3] * cs1[3]; o2[3] = x2[3] * cs1[2] + x1[3] * cs1[3];
                        const int hl = 2 * bj + (wc >> 1); const int head = (pn == 8 ? 0 : 4 * pn) + hl;
                        *(u32x4*)(dst + (size_t)row * ld + head * 64 + 8 * q) = pack8(o1, o2); } }
        } else if ((pn >= 10 && pn < 18) || pn == 20 || pn == 22) {
            const int q = 4 * wc + fq; const f32x4* rt = (const f32x4*)(ws + WS_ROPE128);
            bf16* dst = (bf16*)(ws + (pn == 20 ? WS_KS : pn == 22 ? WS_KW : WS_QBR)); const int ld = pn >= 20 ? 256 : 2048; bf16* q0 = (bf16*)(ws + WS_QB0);
#pragma unroll
            for (int ai = 0; ai < 2; ++ai)
#pragma unroll
                for (int m = 0; m < 4; ++m) { const int row = row0 + ai * HALF + m * 16; const f32x4* rr = rt + (size_t)row * 32 + 2 * q; const f32x4 cs0 = rr[0], cs1 = rr[1];
#pragma unroll
                    for (int bj = 0; bj < 2; ++bj) { const f32x4 x1 = acc[ai][bj][m][0], x2 = acc[ai][bj][m][1]; f32x4 o1, o2;
                        o1[0] = x1[0] * cs0[0] - x2[0] * cs0[1]; o2[0] = x2[0] * cs0[0] + x1[0] * cs0[1];
                        o1[1] = x1[1] * cs0[2] - x2[1] * cs0[3]; o2[1] = x2[1] * cs0[2] + x1[1] * cs0[3];
                        o1[2] = x1[2] * cs1[0] - x2[2] * cs1[1]; o2[2] = x2[2] * cs1[0] + x1[2] * cs1[1];
                        o1[3] = x1[3] * cs1[2] - x2[3] * cs1[3]; o2[3] = x2[3] * cs1[2] + x1[3] * cs1[3];
                        const int head = (pn >= 20 ? 0 : 2 * (pn - 10)) + bj;
                        *(u32x4*)(dst + (size_t)row * ld + head * 128 + 8 * q) = pack8(o1, o2);
                        if (pn < 18) { u32x2 a, b; a.x = cvt_pk_bf16(x1[0], x1[1]); a.y = cvt_pk_bf16(x1[2], x1[3]); b.x = cvt_pk_bf16(x2[0], x2[1]); b.y = cvt_pk_bf16(x2[2], x2[3]);
                            *(u32x2*)(q0 + (size_t)row * 2048 + head * 128 + 4 * q) = a; *(u32x2*)(q0 + (size_t)row * 2048 + head * 128 + 64 + 4 * q) = b; } } }
        } else if (pn == 18 || pn == 19) {
            bf16* dst = (bf16*)(ws + (pn == 18 ? WS_KC : WS_VC)); const int col0 = wc * 32 + 8 * fq;
#pragma unroll
            for (int ai = 0; ai < 2; ++ai)
#pragma unroll
                for (int m = 0; m < 4; ++m)
#pragma unroll
                    for (int bj = 0; bj < 2; ++bj) *(u32x4*)(dst + (size_t)(row0 + ai * HALF + m * 16) * 256 + col0 + bj * HALF) = pack8(acc[ai][bj][m][0], acc[ai][bj][m][1]);
        } else {
            bf16* dst = (bf16*)(ws + (pn == 9 ? WS_VAT : pn == 21 ? WS_VST : WS_VWT));
#pragma unroll
            for (int ai = 0; ai < 2; ++ai)
#pragma unroll
                for (int m = 0; m < 4; ++m) { const int row = row0 + ai * HALF + m * 16; const int b = row / T, t = row % T;
#pragma unroll
                    for (int bj = 0; bj < 2; ++bj) {
                        const int c0 = bj * HALF + wc * 32 + 8 * fq;
                        bf16* p = dst + ((size_t)b * 256 + c0) * T + t;
                        const f32x4 a = acc[ai][bj][m][0], c = acc[ai][bj][m][1];
#pragma unroll
                        for (int j = 0; j < 4; ++j) { p[(size_t)j * T] = (bf16)(cvt_pk_bf16(a[j], 0.f) & 0xffffu); p[(size_t)(4 + j) * T] = (bf16)(cvt_pk_bf16(c[j], 0.f) & 0xffffu); } } }
        }
    }
};
}

#define XB_TMO      128
#define XB_XCNT(j)  (256  + 64 * (j))
#define XB_XSUB(j)  (1280 + 64 * (j))
#define XB_XGEN(j)  (2304 + 64 * (j))
#define XB_TOP      3328
#define XB_TOPGEN   3392
#define XCD_BAR_WORDS 3456
#define XB_SPIN_CAP (1u << 18)
__device__ __forceinline__ unsigned xb_ld(unsigned* p)              { return __hip_atomic_load(p, __ATOMIC_RELAXED, __HIP_MEMORY_SCOPE_AGENT); }
__device__ __forceinline__ unsigned xb_add(unsigned* p, unsigned v) { return __hip_atomic_fetch_add(p, v, __ATOMIC_RELAXED, __HIP_MEMORY_SCOPE_AGENT); }
__device__ __forceinline__ unsigned xb_xcc_id() { return (unsigned)__builtin_amdgcn_s_getreg((3 << 11) | 20) & 0xFu; }
#define XB_SPIN(cond, bar) do { unsigned _sp = 0; while (cond) { __builtin_amdgcn_s_sleep(1); \
    if ((++_sp & 255u) == 0u) { if (xb_ld(&(bar)[XB_TMO])) break; if (_sp > XB_SPIN_CAP) { atomicAdd(&(bar)[XB_TMO], 1u); break; } } } } while (0)
struct XcdBarrier { unsigned* bar; unsigned x; volatile LAS unsigned* st; };
__device__ __forceinline__ XcdBarrier xcd_barrier_post(unsigned* bar, volatile LAS unsigned* st) {
    XcdBarrier b; b.bar = bar; b.x = xb_xcc_id(); b.st = st;
    if (threadIdx.x == 0) (void)xb_add(&bar[XB_XCNT(b.x)], 1u);
    return b;
}
__device__ __forceinline__ void xcd_barrier_complete(unsigned* bar, unsigned x, unsigned& nloc, unsigned& nx) {
    const unsigned G = gridDim.x * gridDim.y * gridDim.z;
    unsigned sum, cnt, mine, sp = 0u;
    for (;;) {
        sum = 0u; cnt = 0u; mine = 0u;
#pragma unroll
        for (unsigned j = 0; j < 16; ++j) { const unsigned c = xb_ld(&bar[XB_XCNT(j)]); sum += c; cnt += (c > 0u) ? 1u : 0u; mine = (j == x) ? c : mine; }
        if (sum == G) break;
        __builtin_amdgcn_s_sleep(1);
        if ((++sp & 255u) == 0u) { if (xb_ld(&bar[XB_TMO])) break; if (sp > XB_SPIN_CAP) { atomicAdd(&bar[XB_TMO], 1u); break; } }
    }
    nloc = mine > 0u ? mine : 1u; nx = cnt > 0u ? cnt : 1u;
}
__device__ __forceinline__ void xcd_barrier(const XcdBarrier& b) {
    asm volatile("s_waitcnt vmcnt(0)" ::: "memory");
    __syncthreads();
    if (threadIdx.x == 0) {
        unsigned* bar = b.bar;
        __builtin_amdgcn_s_waitcnt(0);
        unsigned nloc = b.st[0], nx = b.st[1];
        if (nloc == 0u) { xcd_barrier_complete(bar, b.x, nloc, nx); b.st[0] = nloc; b.st[1] = nx; }
        const unsigned old = xb_add(&bar[XB_XSUB(b.x)], 1u);
        const unsigned gen = old / nloc;
        if (old + 1u == (gen + 1u) * nloc) {
            __builtin_amdgcn_fence(__ATOMIC_RELEASE, "agent");
            asm volatile("s_waitcnt vmcnt(0)" ::: "memory");
            const unsigned og = xb_add(&bar[XB_TOP], 1u);
            const unsigned tg = og / nx;
            if (og + 1u == (tg + 1u) * nx) xb_add(&bar[XB_TOPGEN], 1u);
            else XB_SPIN(xb_ld(&bar[XB_TOPGEN]) == tg, bar);
            __builtin_amdgcn_fence(__ATOMIC_ACQUIRE, "agent");
            xb_add(&bar[XB_XGEN(b.x)], 1u);
            asm volatile("s_waitcnt vmcnt(0)" ::: "memory");
        } else {
            XB_SPIN(xb_ld(&bar[XB_XGEN(b.x)]) == gen, bar);
            __builtin_amdgcn_fence(__ATOMIC_ACQUIRE, "agent");
            asm volatile("s_waitcnt vmcnt(0)" ::: "memory");
        }
    }
    __syncthreads();
}

enum { MAP_ID = 0, MAP_GATE = 1, MAP_UP = 2, MAP_WIN = 3, MAP_BLK = 4 };
__device__ __forceinline__ long win_row_off(int j) {
    if (j >= 6144) {
        if (j < 6192) return (long)((WS_WG - WS_WIN) / 2) + (long)(j - 6144) * DM;
        return (long)(j - 48) * DM;
    }
    int s = j;
    if (j < 2304) { const int d = j & 63, h = j & ~63; s = h + (d < 32 ? 8 * (d >> 2) + (d & 3) : 8 * ((d - 32) >> 2) + 4 + (d & 3)); }
    else if ((j >= 2560 && j < 4608) || (j >= 5120 && j < 5376) || (j >= 5632 && j < 5888)) { const int d = j & 127, h = j & ~127; s = h + (d < 64 ? 8 * (d >> 2) + (d & 3) : 8 * ((d - 64) >> 2) + 4 + (d & 3)); }
    return (long)s * DM;
}
__device__ __forceinline__ long map_row_off(int map, int ns, int K) {
    if (map == MAP_ID) return (long)ns * K;
    if (map == MAP_GATE) return (long)((ns >> 7) * 256 + (ns & 127)) * K;
    if (map == MAP_UP) return (long)((ns >> 7) * 256 + 128 + (ns & 127)) * K;
    return win_row_off(ns);
}
__device__ __forceinline__ void tr_item(const float* W, int K, int N, bf16* dst, int map, int item, int lane) {
    const int nblk = (N + 31) / 32, kb = item / nblk, nb = item % nblk, k0 = 64 * kb + 8 * (lane >> 3), n0 = 32 * nb + 4 * (lane & 7);
    if (n0 >= N) return;
    f32x4 v[8];
#pragma unroll
    for (int r = 0; r < 8; ++r) v[r] = *(const f32x4*)(W + (size_t)(k0 + r) * N + n0);
#pragma unroll
    for (int c = 0; c < 4; ++c) {
        u32x4 o; o.x = cvt_pk_bf16(v[0][c], v[1][c]); o.y = cvt_pk_bf16(v[2][c], v[3][c]); o.z = cvt_pk_bf16(v[4][c], v[5][c]); o.w = cvt_pk_bf16(v[6][c], v[7][c]);
        if (map == MAP_BLK) { const int n = n0 + c; *(u32x4*)(dst + (((size_t)(n >> 8) * (K >> 6) + (k0 >> 6)) * 256 + (n & 255)) * 64 + (k0 & 63)) = o; }
        else *(u32x4*)(dst + map_row_off(map, n0 + c, K) + k0) = o;
    }
}
__device__ __forceinline__ void tr_item2(const float* W, int K, int N, bf16* dst, int map, int itemA, int itemB, int lane) {
    const int nblk = N / 32;
    const int kA = 64 * (itemA / nblk) + 8 * (lane >> 3), nA = 32 * (itemA % nblk) + 4 * (lane & 7);
    const int kB = 64 * (itemB / nblk) + 8 * (lane >> 3), nB = 32 * (itemB % nblk) + 4 * (lane & 7);
    f32x4 va[8], vb[8];
#pragma unroll
    for (int r = 0; r < 8; ++r) va[r] = *(const f32x4*)(W + (size_t)(kA + r) * N + nA);
#pragma unroll
    for (int r = 0; r < 8; ++r) vb[r] = *(const f32x4*)(W + (size_t)(kB + r) * N + nB);
#pragma unroll
    for (int c = 0; c < 4; ++c) {
        u32x4 o; o.x = cvt_pk_bf16(va[0][c], va[1][c]); o.y = cvt_pk_bf16(va[2][c], va[3][c]); o.z = cvt_pk_bf16(va[4][c], va[5][c]); o.w = cvt_pk_bf16(va[6][c], va[7][c]);
        if (map == MAP_BLK) { const int n = nA + c; *(u32x4*)(dst + (((size_t)(n >> 8) * (K >> 6) + (kA >> 6)) * 256 + (n & 255)) * 64 + (kA & 63)) = o; }
        else *(u32x4*)(dst + map_row_off(map, nA + c, K) + kA) = o;
    }
#pragma unroll
    for (int c = 0; c < 4; ++c) {
        u32x4 o; o.x = cvt_pk_bf16(vb[0][c], vb[1][c]); o.y = cvt_pk_bf16(vb[2][c], vb[3][c]); o.z = cvt_pk_bf16(vb[4][c], vb[5][c]); o.w = cvt_pk_bf16(vb[6][c], vb[7][c]);
        if (map == MAP_BLK) { const int n = nB + c; *(u32x4*)(dst + (((size_t)(n >> 8) * (K >> 6) + (kB >> 6)) * 256 + (n & 255)) * 64 + (kB & 63)) = o; }
        else *(u32x4*)(dst + map_row_off(map, nB + c, K) + kB) = o;
    }
}
struct MatDesc { const float* W; bf16* dst; int K, N, map, items; };
__device__ __forceinline__ int items_of(int K, int N) { return (K / 64) * ((N + 31) / 32); }

__device__ __forceinline__ void norm_row_bf16(const float* xrow, const float* g, bf16* orow, int lane) {
    asm volatile("" : "+v"(lane));
    const f32x4* xr = (const f32x4*)xrow + lane; const f32x4* gr = (const f32x4*)g + lane;
    f32x4 v[16]; float s = 0.f;
#pragma unroll
    for (int j = 0; j < 16; ++j) { v[j] = xr[64 * j]; s += (v[j].x * v[j].x + v[j].y * v[j].y) + (v[j].z * v[j].z + v[j].w * v[j].w); }
    const float r = 1.0f / sqrtf(wave_sum(s) * (1.0f / DM) + EPS);
    u32x2* o8 = (u32x2*)orow + lane;
#pragma unroll
    for (int j = 0; j < 16; ++j) { const f32x4 gg = gr[64 * j]; u32x2 w; w.x = cvt_pk_bf16(v[j].x * r * gg.x, v[j].y * r * gg.y); w.y = cvt_pk_bf16(v[j].z * r * gg.z, v[j].w * r * gg.w); o8[64 * j] = w; }
}
__device__ __forceinline__ void norm_row_f32_inplace(float* xrow, const float* g, int lane) {
    asm volatile("" : "+v"(lane));
    f32x4* xr = (f32x4*)xrow + lane; const f32x4* gr = (const f32x4*)g + lane;
    f32x4 v[16]; float s = 0.f;
#pragma unroll
    for (int j = 0; j < 16; ++j) { v[j] = xr[64 * j]; s += (v[j].x * v[j].x + v[j].y * v[j].y) + (v[j].z * v[j].z + v[j].w * v[j].w); }
    const float r = 1.0f / sqrtf(wave_sum(s) * (1.0f / DM) + EPS);
#pragma unroll
    for (int j = 0; j < 16; ++j) { const f32x4 gg = gr[64 * j]; xr[64 * j] = (f32x4){v[j].x * r * gg.x, v[j].y * r * gg.y, v[j].z * r * gg.z, v[j].w * r * gg.w}; }
}
__device__ __forceinline__ void sincos_d(double a, float& c, float& s) {
    const double k = __builtin_rint(a * 0.6366197723675814);
    double r = (a - k * 1.5707963109016418) - k * 1.5893254773528196e-08;
    const double r2 = r * r;
    double sn = r2 * (1.0 / 6227020800.0) - (1.0 / 39916800.0); sn = sn * r2 + (1.0 / 362880.0); sn = sn * r2 - (1.0 / 5040.0); sn = sn * r2 + (1.0 / 120.0); sn = sn * r2 - (1.0 / 6.0); sn = sn * r2 * r + r;
    double cn = r2 * (-1.0 / 87178291200.0) + (1.0 / 479001600.0); cn = cn * r2 - (1.0 / 3628800.0); cn = cn * r2 + (1.0 / 40320.0); cn = cn * r2 - (1.0 / 720.0); cn = cn * r2 + (1.0 / 24.0); cn = cn * r2 - 0.5; cn = cn * r2 + 1.0;
    const int q = ((int)k) & 3;
    const double cc = (q == 0) ? cn : (q == 1) ? -sn : (q == 2) ? -cn : sn;
    const double ss = (q == 0) ? sn : (q == 1) ? cn : (q == 2) ? -sn : -cn;
    c = (float)cc; s = (float)ss;
}

#define MFMA16(a, b, c) __builtin_amdgcn_mfma_f32_16x16x32_bf16((a), (b), (c), 0, 0, 0)
template <int D> struct KVRegs { bf16x8 ka[D / 32], kb[D / 32], v[D / 16]; };
template <int D> struct AttnW { bf16x8 q[D / 32]; f32x4 O[D / 16]; float m, l; };

template <int D> __device__ __forceinline__ void attn_load_q(AttnW<D>& w, const bf16* qrow  , int quad) {
#pragma unroll
    for (int kk = 0; kk < D / 32; ++kk) w.q[kk] = *(const bf16x8*)(qrow + kk * 32 + quad * 8);
}
typedef __amdgpu_buffer_rsrc_t rsrc_t;
__device__ __forceinline__ rsrc_t make_rsrc(const void* p) { return __builtin_amdgcn_make_buffer_rsrc((void*)p, 0, 0x7fffffff, 0x00020000); }
__device__ __forceinline__ bf16x8 buf_ld16(rsrc_t r, unsigned voff, unsigned soff) { const u32x4 v = __builtin_amdgcn_raw_buffer_load_b128(r, voff, soff, 0); return __builtin_bit_cast(bf16x8, v); }
template <int D> __device__ __forceinline__ void attn_load_k(KVRegs<D>& r, rsrc_t Kb, int ldk, int key0, int lane) {
    const int rho = lane & 15, quad = lane >> 4;
    const unsigned lo = (unsigned)(((8 * (rho >> 2) + (rho & 3)) * ldk + quad * 8) * 2);
    const unsigned so = (unsigned)(key0 * ldk * 2);
#pragma unroll
    for (int kk = 0; kk < D / 32; ++kk) { r.ka[kk] = buf_ld16(Kb, lo, so + kk * 64); r.kb[kk] = buf_ld16(Kb, lo, so + 8 * ldk + kk * 64); }
}
template <int D> __device__ __forceinline__ void attn_load_v(KVRegs<D>& r, rsrc_t Vt, int ldv, int key0, int lane) {
    const int rho = lane & 15, quad = lane >> 4;
    const unsigned lo = (unsigned)((rho * ldv + 8 * quad) * 2);
#pragma unroll
    for (int dt = 0; dt < D / 16; ++dt) r.v[dt] = buf_ld16(Vt, lo, (unsigned)((key0 + dt * 16 * ldv) * 2));
}
template <int D> __device__ __forceinline__ void attn_scores(const AttnW<D>& w, const KVRegs<D>& r, f32x4& sa, f32x4& sb) {
    sa = (f32x4){0.f, 0.f, 0.f, 0.f}; sb = sa;
#pragma unroll
    for (int kk = 0; kk < D / 32; ++kk) { sa = MFMA16(r.ka[kk], w.q[kk], sa); sb = MFMA16(r.kb[kk], w.q[kk], sb); }
}
template <int D> __device__ __forceinline__ void attn_softmax_pv(AttnW<D>& w, const KVRegs<D>& r, const float (&s)[8]) {
    float mx = fmaxf(fmaxf(fmaxf(s[0], s[1]), fmaxf(s[2], s[3])), fmaxf(fmaxf(s[4], s[5]), fmaxf(s[6], s[7])));
    mx = rows4_max(mx);
    const float mn = fmaxf(w.m, mx); const float alpha = __builtin_amdgcn_exp2f(w.m - mn); w.m = mn;
    float p[8]; float ps = 0.f;
#pragma unroll
    for (int i = 0; i < 8; ++i) { p[i] = __builtin_amdgcn_exp2f(s[i] - mn); ps += p[i]; }
    w.l = w.l * alpha + ps;
#pragma unroll
    for (int dt = 0; dt < D / 16; ++dt) w.O[dt] = w.O[dt] * alpha;
    u32x4 pw; pw.x = cvt_pk_bf16(p[0], p[1]); pw.y = cvt_pk_bf16(p[2], p[3]); pw.z = cvt_pk_bf16(p[4], p[5]); pw.w = cvt_pk_bf16(p[6], p[7]);
    const bf16x8 pf = __builtin_bit_cast(bf16x8, pw);
#pragma unroll
    for (int dt = 0; dt < D / 16; ++dt) w.O[dt] = MFMA16(r.v[dt], pf, w.O[dt]);
}
constexpr float NEG_INF = -__builtin_huge_valf();

template <int D, class KeyF, class MaskF>
__device__ __forceinline__ void attn_stream_pv(AttnW<D>& w, rsrc_t Kb, int ldk, rsrc_t Vt, int ldv, int n, int lane, KeyF keyf, MaskF maskf) {
    if (n <= 0) return;
    KVRegs<D> ra, rb;
    int k0a = keyf(0), k0b = 0;
    attn_load_k<D>(ra, Kb, ldk, k0a, lane); attn_load_v<D>(ra, Vt, ldv, k0a, lane);
    for (int i = 0; i < n; i += 2) {
        const bool has1 = i + 1 < n;
        if (has1) { k0b = keyf(i + 1); attn_load_k<D>(rb, Kb, ldk, k0b, lane); }
        __builtin_amdgcn_sched_barrier(0);
        { f32x4 sa, sb; attn_scores<D>(w, ra, sa, sb); float s[8]; maskf(sa, sb, k0a, i, s);
          __builtin_amdgcn_sched_barrier(0);
          if (has1) attn_load_v<D>(rb, Vt, ldv, k0b, lane);
          __builtin_amdgcn_sched_barrier(0);
          attn_softmax_pv<D>(w, ra, s); }
        __builtin_amdgcn_sched_barrier(0);
        if (has1) {
            const bool has2 = i + 2 < n;
            if (has2) { k0a = keyf(i + 2); attn_load_k<D>(ra, Kb, ldk, k0a, lane); }
            __builtin_amdgcn_sched_barrier(0);
            f32x4 sa, sb; attn_scores<D>(w, rb, sa, sb); float s[8]; maskf(sa, sb, k0b, i + 1, s);
            __builtin_amdgcn_sched_barrier(0);
            if (has2) attn_load_v<D>(ra, Vt, ldv, k0a, lane);
            __builtin_amdgcn_sched_barrier(0);
            attn_softmax_pv<D>(w, rb, s);
            __builtin_amdgcn_sched_barrier(0);
        }
    }
}
template <int D> __device__ __forceinline__ void attn_band(AttnW<D>& w, rsrc_t Kb, int ldk, rsrc_t Vt, int ldv, int t0, int window, float sc, int lane) {
    const int quad = lane >> 4, tcol = t0 + ((lane >> 3) & 1);
    int lo = t0 - (window - 1); if (lo < 0) lo = 0;
    const int c0 = lo >> 5, c1 = (t0 + 1) >> 5;
    attn_stream_pv<D>(w, Kb, ldk, Vt, ldv, c1 - c0 + 1, lane, [=](int i) { return (c0 + i) * 32; }, [=](const f32x4& sa, const f32x4& sb, int k0, int, float (&s)[8]) {
        const int kb = k0 + 8 * quad;
#pragma unroll
        for (int i = 0; i < 4; ++i) { const int d0 = tcol - (kb + i), d1 = tcol - (kb + 4 + i); s[i] = ((unsigned)d0 < (unsigned)window) ? sa[i] * sc : NEG_INF; s[4 + i] = ((unsigned)d1 < (unsigned)window) ? sb[i] * sc : NEG_INF; } });
}
template <int D> __device__ __forceinline__ float attn_finish_l(const AttnW<D>& w) { return rows4_sum(w.l); }

__device__ __forceinline__ void mixer_a_task(unsigned char* ws, const float* sinks, int b, int kvh, int tp, int lane) {
    const int c = lane & 15, quad = lane >> 4, t0 = 2 * tp, tok = t0 + (c >> 3), head = kvh * 8 + (c & 7);
    const bf16* QA = (const bf16*)(ws + WS_QA); const bf16* KA = (const bf16*)(ws + WS_KA) + (size_t)b * T * 256 + kvh * 64; const bf16* VAT = (const bf16*)(ws + WS_VAT) + ((size_t)b * 256 + kvh * 64) * T;
    AttnW<64> w;
    attn_load_q<64>(w, QA + (size_t)(b * T + tok) * 2048 + head * 64, quad);
#pragma unroll
    for (int dt = 0; dt < 4; ++dt) w.O[dt] = (f32x4){0.f, 0.f, 0.f, 0.f};
    w.m = sinks[head] * LOG2E; w.l = (quad == 0) ? 1.0f : 0.0f;
    attn_band<64>(w, make_rsrc(KA), 256, make_rsrc(VAT), T, t0, AWIN, 0.125f * LOG2E, lane);
    const float inv = 1.0f / attn_finish_l<64>(w);
    bf16* orow = (bf16*)(ws + WS_OA) + (size_t)(b * T + tok) * 2048 + head * 64;
#pragma unroll
    for (int dt = 0; dt < 4; ++dt) { u32x2 o; o.x = cvt_pk_bf16(w.O[dt][0] * inv, w.O[dt][1] * inv); o.y = cvt_pk_bf16(w.O[dt][2] * inv, w.O[dt][3] * inv); *(u32x2*)(orow + 16 * dt + 4 * quad) = o; }
}
__device__ __forceinline__ void mixer_a_task4(unsigned char* ws, const float* sinks, int b, int kvh, int tq, int lane) {
    const int c = lane & 15, quad = lane >> 4, t0 = 4 * tq, head = kvh * 8 + (c & 7);
    const bf16* QA = (const bf16*)(ws + WS_QA); const bf16* KA = (const bf16*)(ws + WS_KA) + (size_t)b * T * 256 + kvh * 64; const bf16* VAT = (const bf16*)(ws + WS_VAT) + ((size_t)b * 256 + kvh * 64) * T;
    const rsrc_t Kb = make_rsrc(KA), Vt = make_rsrc(VAT);
    AttnW<64> w0, w1; const int tokA = t0 + (c >> 3), tokB = tokA + 2;
    attn_load_q<64>(w0, QA + (size_t)(b * T + tokA) * 2048 + head * 64, quad); attn_load_q<64>(w1, QA + (size_t)(b * T + tokB) * 2048 + head * 64, quad);
#pragma unroll
    for (int dt = 0; dt < 4; ++dt) { w0.O[dt] = (f32x4){0.f, 0.f, 0.f, 0.f}; w1.O[dt] = w0.O[dt]; }
    w0.m = sinks[head] * LOG2E; w0.l = (quad == 0) ? 1.0f : 0.0f; w1.m = w0.m; w1.l = w0.l;
    const float sc = 0.125f * LOG2E;
    int lo = t0 - (AWIN - 1); if (lo < 0) lo = 0;
    const int c0 = lo >> 5, c1 = (t0 + 3) >> 5, n = c1 - c0 + 1;
    auto step = [&](const KVRegs<64>& r, int k0) {
        const int kb = k0 + 8 * quad;
        { f32x4 sa, sb; attn_scores<64>(w0, r, sa, sb); float s[8];
#pragma unroll
          for (int i = 0; i < 4; ++i) { s[i] = ((unsigned)(tokA - (kb + i)) < (unsigned)AWIN) ? sa[i] * sc : NEG_INF; s[4 + i] = ((unsigned)(tokA - (kb + 4 + i)) < (unsigned)AWIN) ? sb[i] * sc : NEG_INF; }
          attn_softmax_pv<64>(w0, r, s); }
        { f32x4 sa, sb; attn_scores<64>(w1, r, sa, sb); float s[8];
#pragma unroll
          for (int i = 0; i < 4; ++i) { s[i] = ((unsigned)(tokB - (kb + i)) < (unsigned)AWIN) ? sa[i] * sc : NEG_INF; s[4 + i] = ((unsigned)(tokB - (kb + 4 + i)) < (unsigned)AWIN) ? sb[i] * sc : NEG_INF; }
          attn_softmax_pv<64>(w1, r, s); }
    };
    KVRegs<64> ra, rb;
    attn_load_k<64>(ra, Kb, 256, c0 * 32, lane); attn_load_v<64>(ra, Vt, T, c0 * 32, lane);
    for (int i = 0; i < n; i += 2) {
        const bool has1 = i + 1 < n;
        if (has1) { attn_load_k<64>(rb, Kb, 256, (c0 + i + 1) * 32, lane); attn_load_v<64>(rb, Vt, T, (c0 + i + 1) * 32, lane); }
        step(ra, (c0 + i) * 32);
        if (has1) {
            if (i + 2 < n) { attn_load_k<64>(ra, Kb, 256, (c0 + i + 2) * 32, lane); attn_load_v<64>(ra, Vt, T, (c0 + i + 2) * 32, lane); }
            step(rb, (c0 + i + 1) * 32);
        }
    }
    const float invA = 1.0f / attn_finish_l<64>(w0), invB = 1.0f / attn_finish_l<64>(w1);
    bf16* orowA = (bf16*)(ws + WS_OA) + (size_t)(b * T + tokA) * 2048 + head * 64; bf16* orowB = (bf16*)(ws + WS_OA) + (size_t)(b * T + tokB) * 2048 + head * 64;
#pragma unroll
    for (int dt = 0; dt < 4; ++dt) {
        u32x2 o; o.x = cvt_pk_bf16(w0.O[dt][0] * invA, w0.O[dt][1] * invA); o.y = cvt_pk_bf16(w0.O[dt][2] * invA, w0.O[dt][3] * invA); *(u32x2*)(orowA + 16 * dt + 4 * quad) = o;
        u32x2 p; p.x = cvt_pk_bf16(w1.O[dt][0] * invB, w1.O[dt][1] * invB); p.y = cvt_pk_bf16(w1.O[dt][2] * invB, w1.O[dt][3] * invB); *(u32x2*)(orowB + 16 * dt + 4 * quad) = p;
    }
}
__device__ __forceinline__ void gates_task(unsigned char* ws, int rt, int lane) {
    const int rho = lane & 15, quad = lane >> 4;
    const bf16* xr = (const bf16*)(ws + WS_XN) + (size_t)(rt * 16 + rho) * DM + quad * 8;
    const bf16* wg = (const bf16*)(ws + WS_WG) + (size_t)rho * DM + quad * 8;
    f32x4 acc[3];
#pragma unroll
    for (int g = 0; g < 3; ++g) acc[g] = (f32x4){0.f, 0.f, 0.f, 0.f};
#pragma unroll 1
    for (int ch = 0; ch < 32; ++ch) {
        bf16x8 xb[4], wa[3][4];
#pragma unroll
        for (int kk = 0; kk < 4; ++kk) xb[kk] = *(const bf16x8*)(xr + ch * 128 + kk * 32);
#pragma unroll
        for (int g = 0; g < 3; ++g)
#pragma unroll
            for (int kk = 0; kk < 4; ++kk) wa[g][kk] = *(const bf16x8*)(wg + (size_t)g * 16 * DM + ch * 128 + kk * 32);
#pragma unroll
        for (int g = 0; g < 3; ++g)
#pragma unroll
            for (int kk = 0; kk < 4; ++kk) acc[g] = MFMA16(wa[g][kk], xb[kk], acc[g]);
    }
    float* o = (float*)(ws + WS_SGN) + (size_t)(rt * 16 + rho) * 48 + 4 * quad;
#pragma unroll
    for (int g = 0; g < 3; ++g) { f32x4 s; for (int i = 0; i < 4; ++i) s[i] = fast_sigmoid(acc[g][i]); *(f32x4*)(o + 16 * g) = s; }
}
__device__ __forceinline__ float gelu_tanh(float x) {
    const float u = 0.7978845608028654f * (x + 0.044715f * x * x * x);
    const float e = __builtin_amdgcn_exp2f(-2.0f * LOG2E * fabsf(u)); const float th = (1.0f - e) * __builtin_amdgcn_rcpf(1.0f + e);
    return 0.5f * x * (1.0f + (u < 0.f ? -th : th));
}
__device__ __forceinline__ void compress_task(unsigned char* ws, LAS unsigned char* lds, int task, int wave, int lane) {
    const int x = task >> 7, b = (task >> 6) & 1, g = (task >> 5) & 1, c0 = (task & 31) * 16;
    const int rho = lane & 15, quad = lane >> 4;
    const bf16* src = (const bf16*)(ws + (x ? WS_VC : WS_KC)) + (size_t)b * T * 256 + g * 128 + quad * 8;
    const bf16* w1 = (const bf16*)(ws + (x ? WS_CV1 : WS_CK1)) + (size_t)rho * 4096 + quad * 8;
    f32x4 acc[8];
#pragma unroll
    for (int h = 0; h < 8; ++h) acc[h] = (f32x4){0.f, 0.f, 0.f, 0.f};
#pragma unroll 1
    for (int li = 0; li < 4; ++li) {
        const int l = wave * 4 + li; int tok = 16 * (c0 + rho) + l; if (tok > T - 1) tok = T - 1;
        bf16x8 xb[4];
#pragma unroll
        for (int kk = 0; kk < 4; ++kk) xb[kk] = *(const bf16x8*)(src + (size_t)tok * 256 + kk * 32);
#pragma unroll
        for (int hh = 0; hh < 2; ++hh) {
            bf16x8 wa[4][4];
#pragma unroll
            for (int h = 0; h < 4; ++h)
#pragma unroll
                for (int kk = 0; kk < 4; ++kk) wa[h][kk] = *(const bf16x8*)(w1 + (size_t)(hh * 4 + h) * 16 * 4096 + l * 128 + kk * 32);
#pragma unroll
            for (int h = 0; h < 4; ++h)
#pragma unroll
                for (int kk = 0; kk < 4; ++kk) acc[hh * 4 + h] = MFMA16(wa[h][kk], xb[kk], acc[hh * 4 + h]);
        }
    }
    LAS float* part = (LAS float*)lds;
    LAS bf16* g2 = (LAS bf16*)(lds + 65536);
#pragma unroll
    for (int h = 0; h < 8; ++h)
#pragma unroll
        for (int i = 0; i < 4; ++i) part[(wave * 128 + 16 * h + 4 * quad + i) * 16 + rho] = acc[h][i];
    __syncthreads();
    {
        const float* cbp = (const float*)(ws + WS_CBP) + x * 16 * 128;
        float hv[4];
#pragma unroll
        for (int i = 0; i < 4; ++i) { const int hid = 16 * wave + 4 * quad + i; float s = 0.f;
#pragma unroll
            for (int pw = 0; pw < 8; ++pw) s += part[(pw * 128 + hid) * 16 + rho];
            float bsum = 0.f;
#pragma unroll
            for (int kc = 0; kc < 16; ++kc) bsum += cbp[kc * 128 + hid];
            hv[i] = gelu_tanh(s + bsum); }
        u32x2 o; o.x = cvt_pk_bf16(hv[0], hv[1]); o.y = cvt_pk_bf16(hv[2], hv[3]);
        *(LAS u32x2*)(g2 + rho * 128 + 16 * wave + 4 * quad) = o;
    }
    __syncthreads();
    {
        const bf16* w2 = (const bf16*)(ws + (x ? WS_CV2 : WS_CK2)) + (size_t)(16 * wave + rho) * 128 + 8 * quad;
        f32x4 o = (f32x4){0.f, 0.f, 0.f, 0.f};
#pragma unroll
        for (int s = 0; s < 4; ++s) { const bf16x8 a = *(const bf16x8*)(w2 + 32 * s); const bf16x8 bb = *(const LAS bf16x8*)(g2 + rho * 128 + 32 * s + 8 * quad); o = MFMA16(a, bb, o); }
        const int c = c0 + rho, d0 = 16 * wave + 4 * quad;
        if (x == 0) { bf16* kc = (bf16*)(ws + WS_KCMP) + ((size_t)(b * 2 + g) * NCP + c) * 128 + d0; u32x2 p; p.x = cvt_pk_bf16(o[0], o[1]); p.y = cvt_pk_bf16(o[2], o[3]); *(u32x2*)kc = p; }
        else { bf16* vc = (bf16*)(ws + WS_VCMPT) + ((size_t)(b * 2 + g) * 128 + d0) * NCP + c;
#pragma unroll
            for (int i = 0; i < 4; ++i) vc[(size_t)i * NCP] = (bf16)(cvt_pk_bf16(o[i], 0.f) & 0xffffu); }
    }
    __syncthreads();
}

constexpr int G_TOK = 14, G_NCONS = 7, G_SLOTS = 4, G_SLOT_BYTES = 32768, G_NGROUP = (T + G_TOK - 1) / G_TOK;
#ifndef G_VPRE
#define G_VPRE 14
#endif
constexpr int GX_OFF = 131072 + 512;
constexpr int GX_DESC = GX_OFF, GX_NDESC = 192;
constexpr int GX_CTL = GX_DESC + GX_NDESC * 4;
constexpr int GX_TAB = GX_CTL + 128;
constexpr int GX_WAVE = GX_TAB + 64, GX_WAVE_BYTES = 1152;
static_assert(GX_WAVE + 8 * GX_WAVE_BYTES <= 147456, "P6 LDS map");
constexpr float G_THR = 8.0f;
constexpr unsigned G_SPIN_CAP = 1u << 22;
__device__ __forceinline__ unsigned g_lds_ld(unsigned addr) { unsigned v; asm volatile("ds_read_b32 %0, %1\n\ts_waitcnt lgkmcnt(0)" : "=v"(v) : "v"(addr) : "memory"); return v; }
__device__ __forceinline__ void g_lds_st(unsigned addr, unsigned v) { asm volatile("ds_write_b32 %0, %1" :: "v"(addr), "v"(v) : "memory"); }
__device__ __forceinline__ void g_wait_ge(unsigned addr, unsigned want, unsigned tmo_addr) {
    unsigned sp = 0;
    while ((unsigned)__builtin_amdgcn_readfirstlane((int)g_lds_ld(addr)) < want) { __builtin_amdgcn_s_sleep(1); ++sp; if ((sp & 1023u) == 0u && __builtin_amdgcn_readfirstlane((int)g_lds_ld(tmo_addr)) != 0) break; if (sp > G_SPIN_CAP) { g_lds_st(tmo_addr, 1u); break; } }
}
__device__ __forceinline__ void nsa_group_task(unsigned char* ws, LAS unsigned char* lds, int b, int g, int tg, int wave, int lane, const int crip) {
    asm volatile("" : "+v"(lane));
    const int t0 = G_TOK * tg;
    LAS unsigned* desc = (LAS unsigned*)(lds + GX_DESC);
    volatile LAS unsigned* gctl = (volatile LAS unsigned*)(lds + GX_CTL);
    const unsigned A_CTL = (unsigned)(size_t)(lds + GX_CTL);
    const int ntok = (T - t0) < G_TOK ? (T - t0) : G_TOK, nact = (ntok + 1) >> 1;
    const int tlast = t0 + ntok - 1;
    const int nvmax = tlast >= 31 ? ((tlast - 31) >> 4) + 1 : 0; int ncmp = (nvmax + 63) >> 6; if (ncmp < 1) ncmp = 1;
    int wlo = t0 - (BWIN - 1); if (wlo < 0) wlo = 0; const int wc0 = wlo >> 6, wc1 = tlast >> 6, nwin = wc1 - wc0 + 1;
    const int nfix = 2 * ncmp + nwin;
    for (int i = threadIdx.x; i < nfix; i += NWAVES * 64) {
        unsigned d;
        if (i < ncmp) d = 0u | ((unsigned)(i * 64) << 8) | (i == ncmp - 1 ? 4u : 0u);
        else if (i < 2 * ncmp) d = 1u | ((unsigned)((i - ncmp) * 64) << 8) | (i == 2 * ncmp - 1 ? 4u : 0u);
        else d = 2u | ((unsigned)((wc0 + i - 2 * ncmp) * 64) << 8) | (i == nfix - 1 ? 4u : 0u);
        desc[i] = d;
    }
    if (threadIdx.x < 32 && threadIdx.x != 1) gctl[threadIdx.x] = (threadIdx.x == 0) ? (unsigned)nfix : (threadIdx.x >= 16 + nact && threadIdx.x < 16 + G_NCONS) ? 0x7fffffffu : 0u;
    if (threadIdx.x >= 64 && threadIdx.x < 72) {
        const int e = threadIdx.x - 64, kd = e >> 1; const bool isv = e & 1; size_t a;
        if (kd < 2) a = isv ? WS_VCMPT + (size_t)(b * 2 + g) * 128 * NCP * 2 : WS_KCMP + (size_t)(b * 2 + g) * NCP * 128 * 2;
        else if (kd == 2) a = isv ? WS_VWT + ((size_t)b * 256 + g * 128) * T * 2 : WS_KW + ((size_t)b * T * 256 + g * 128) * 2;
        else a = isv ? WS_VST + ((size_t)b * 256 + g * 128) * T * 2 : WS_KS + ((size_t)b * T * 256 + g * 128) * 2;
        ((LAS unsigned long long*)(lds + GX_TAB))[e] = (unsigned long long)(size_t)(ws + a);
    }
    if (wave < G_NCONS) { LAS float* impz = (LAS float*)(lds + GX_WAVE + wave * GX_WAVE_BYTES); for (int i = lane; i < 2 * 136; i += 64) impz[i] = 0.f; }
    LDS_WAIT(); __builtin_amdgcn_s_barrier(); asm volatile("" ::: "memory");
    if (wave >= G_NCONS) {
        const int rho = lane & 15, quad = lane >> 4;
        const unsigned A_RDK = A_CTL + 4 * 2, A_RDV = A_CTL + 4 * 3;
        int nk = nfix, j = 0; bool slc_known = false;
        for (;;) {
            if (j >= nk) {
                asm volatile("s_waitcnt vmcnt(0)" ::: "memory"); g_lds_st(A_RDK, (unsigned)j); g_lds_st(A_RDV, (unsigned)j);
                if (slc_known) break;
                g_wait_ge(A_CTL + 4 * 9, 1u, A_CTL + 4 * 10); nk = __builtin_amdgcn_readfirstlane((int)g_lds_ld(A_CTL)); slc_known = true;
                if (j >= nk) break;
            }
            if (j >= G_SLOTS) {
                const unsigned want = (unsigned)(j - G_SLOTS + 1);
                u32x4 p0, p1;
                asm volatile("ds_read_b128 %0, %2 offset:64\n\tds_read_b128 %1, %2 offset:80\n\ts_waitcnt lgkmcnt(0)" : "=&v"(p0), "=&v"(p1) : "v"(A_CTL) : "memory");
                unsigned mn = p0.x < p0.y ? p0.x : p0.y; { const unsigned m2 = p0.z < p0.w ? p0.z : p0.w; mn = mn < m2 ? mn : m2; } { const unsigned m3 = p1.x < p1.y ? p1.x : p1.y; mn = mn < m3 ? mn : m3; } mn = mn < p1.z ? mn : p1.z;
                if ((unsigned)__builtin_amdgcn_readfirstlane((int)mn) < want) { asm volatile("s_waitcnt vmcnt(0)" ::: "memory"); g_lds_st(A_RDK, (unsigned)j); g_lds_st(A_RDV, (unsigned)j);
#pragma unroll
                    for (int w = 0; w < G_NCONS; ++w) g_wait_ge(A_CTL + 4 * (16 + w), want, A_CTL + 4 * 10); }
            }
            const unsigned d = (unsigned)__builtin_amdgcn_readfirstlane((int)desc[j]); const int kind = (int)(d & 3u), key0 = (int)(d >> 8);
            const LAS unsigned long long* tab = (const LAS unsigned long long*)(lds + GX_TAB);
            LAS unsigned char* slot = lds + (j & (G_SLOTS - 1)) * G_SLOT_BYTES;
            if (!((crip & 2) && kind >= 2)) {
                const int ldk = kind < 2 ? 128 : 256;
                const bf16* src = (const bf16*)(size_t)tab[2 * kind] + (size_t)(key0 + 8 * (rho >> 2) + (rho & 3)) * ldk + quad * 8;
#pragma unroll
                for (int tl = 0; tl < 4; ++tl)
#pragma unroll
                    for (int kk = 0; kk < 4; ++kk) __builtin_amdgcn_global_load_lds((const unsigned*)(src + (size_t)(32 * (tl >> 1) + 4 * (tl & 1)) * ldk + 32 * kk), (LAS unsigned*)(slot + (tl * 4 + kk) * 1024), 16, 0, 0);
            }
            __builtin_amdgcn_s_sleep(3);
            if (!(crip & 2) && kind != 1) {
                const int ldv = kind < 2 ? NCP : T;
                const bf16* src = (const bf16*)(size_t)tab[2 * kind + 1] + (size_t)rho * ldv + key0 + 8 * quad;
#pragma unroll
                for (int dt = 0; dt < 8; ++dt) {
                    __builtin_amdgcn_global_load_lds((const unsigned*)(src + (size_t)dt * 16 * ldv), (LAS unsigned*)(slot + (16 + 2 * dt) * 1024), 16, 0, 0);
                    __builtin_amdgcn_global_load_lds((const unsigned*)(src + (size_t)dt * 16 * ldv + 32), (LAS unsigned*)(slot + (17 + 2 * dt) * 1024), 16, 0, 0);
                }
            }
            ++j;
            if (j >= 2) { if (kind == 1) asm volatile("s_waitcnt vmcnt(16)" ::: "memory"); else asm volatile("s_waitcnt vmcnt(32)" ::: "memory");
                          g_lds_st(A_RDK, (unsigned)(j - 1)); g_lds_st(A_RDV, (unsigned)(j - 1)); }
        }
    } else if (wave < nact) {
        const int c = lane & 15, quad = lane >> 4, tau = c >> 3, tw0 = t0 + 2 * wave, head = g * 8 + (c & 7);
        int tok = tw0 + tau; const bool tok_ok = tok < T; if (!tok_ok) tok = T - 1;
        const size_t row = (size_t)b * T + tok;
        LAS float* imp = (LAS float*)(lds + GX_WAVE + wave * GX_WAVE_BYTES);
        LAS unsigned* selmask = (LAS unsigned*)(lds + GX_WAVE + wave * GX_WAVE_BYTES + 1088);
        const float sc = 0.08838834764831845f * LOG2E;
        const float* sg0 = (const float*)(ws + WS_SGN) + row * 48 + head * 3;
        bf16x8 q[4]; f32x4 O[8], Of[8]; float m = -1e30f, l = 0.f, mfin = 0.f, invc = 0.f;
        { const bf16* qrow = (const bf16*)(ws + WS_QB0) + row * 2048 + head * 128;
#pragma unroll
          for (int kk = 0; kk < 4; ++kk) q[kk] = *(const bf16x8*)(qrow + kk * 32 + quad * 8); }
        const float g_cmp = sg0[0], g_slc = sg0[1], g_win = sg0[2];
#pragma unroll
        for (int dt = 0; dt < 8; ++dt) { O[dt] = (f32x4){0.f, 0.f, 0.f, 0.f}; Of[dt] = O[dt]; }
        const int nvis = tok >= 31 ? ((tok - 31) >> 4) + 1 : 0;
        int nk = nfix; bool slc_known = false;
        unsigned smw[8] = {0u, 0u, 0u, 0u, 0u, 0u, 0u, 0u};
        unsigned dnext = (unsigned)__builtin_amdgcn_readfirstlane((int)desc[0]);
        for (int idx = 0;; ++idx) {
            if (idx >= nk) { if (slc_known) break; g_wait_ge(A_CTL + 4 * 9, 1u, A_CTL + 4 * 10); nk = __builtin_amdgcn_readfirstlane((int)g_lds_ld(A_CTL)); slc_known = true; if (idx >= nk) break; dnext = (unsigned)__builtin_amdgcn_readfirstlane((int)desc[idx]); }
            const unsigned d = dnext; const int kind = (int)(d & 3u), key0 = (int)(d >> 8);
            const int kb = key0 + 8 * quad;
            bool need = true; unsigned sm0 = 0u, sm1 = 0u;
            if (kind == 2) need = (key0 <= tw0 + 1) && (key0 + 63 >= tw0 - (BWIN - 1));
            else if (kind == 3) { const int j = key0 >> 6, jw = j >> 5; const unsigned w0 = jw == 0 ? smw[0] : jw == 1 ? smw[1] : jw == 2 ? smw[2] : smw[3], w1 = jw == 0 ? smw[4] : jw == 1 ? smw[5] : jw == 2 ? smw[6] : smw[7]; sm0 = (w0 >> (j & 31)) & 1u; sm1 = (w1 >> (j & 31)) & 1u; need = (sm0 | sm1) != 0u; }
            if ((crip & 1) && kind >= 2) need = false;
            if (need) {
                const LAS unsigned char* slot = lds + (idx & (G_SLOTS - 1)) * G_SLOT_BYTES + lane * 16;
                g_wait_ge(A_CTL + 4 * 3, (unsigned)idx + 1u, A_CTL + 4 * 10);
                f32x4 sv[4];
                {
                    bf16x8 kf[16];
#pragma unroll
                    for (int kk = 0; kk < 4; ++kk)
#pragma unroll
                        for (int tl = 0; tl < 4; ++tl) kf[kk * 4 + tl] = *(const LAS bf16x8*)(slot + (tl * 4 + kk) * 1024);
                    __builtin_amdgcn_sched_barrier(0);
#pragma unroll
                    for (int tl = 0; tl < 4; ++tl) sv[tl] = (f32x4){0.f, 0.f, 0.f, 0.f};
#pragma unroll
                    for (int kk = 0; kk < 4; ++kk)
#pragma unroll
                        for (int tl = 0; tl < 4; ++tl) sv[tl] = MFMA16(kf[kk * 4 + tl], q[kk], sv[tl]);
                    __builtin_amdgcn_sched_barrier(0);
                }
                if (kind == 1) {
#pragma unroll
                    for (int h = 0; h < 2; ++h) {
                        float p[8]; const int kh = kb + 32 * h;
#pragma unroll
                        for (int i = 0; i < 4; ++i) { p[i] = (kh + i < nvis) ? __builtin_amdgcn_exp2f(sv[2 * h][i] * sc - mfin) * invc : 0.f; p[4 + i] = (kh + 4 + i < nvis) ? __builtin_amdgcn_exp2f(sv[2 * h + 1][i] * sc - mfin) * invc : 0.f; }
                        float A = p[0], B = p[0] + 2.f * (p[1] + p[2] + p[3]) + p[4], C = p[4] + 2.f * (p[5] + p[6] + p[7]);
                        A = heads8_sum(A); B = heads8_sum(B); C = heads8_sum(C);
                        if ((lane & 7) == 0) { LAS float* ip = imp + tau * 136 + (kh >> 2); __hip_atomic_fetch_add(ip, A, __ATOMIC_RELAXED, __HIP_MEMORY_SCOPE_WORKGROUP); __hip_atomic_fetch_add(ip + 1, B, __ATOMIC_RELAXED, __HIP_MEMORY_SCOPE_WORKGROUP); __hip_atomic_fetch_add(ip + 2, C, __ATOMIC_RELAXED, __HIP_MEMORY_SCOPE_WORKGROUP); }
                    }
                } else {
                    bf16x8 vf[16];
#pragma unroll
                    for (int i = 0; i < G_VPRE; ++i) vf[i] = *(const LAS bf16x8*)(slot + (16 + 2 * (i & 7) + (i >> 3)) * 1024);
                    __builtin_amdgcn_sched_barrier(0);
                    float s[16];
                    const int lim = kind == 0 ? nvis - 1 : tok;
                    const unsigned span = kind == 0 ? 0x7fffffffu : kind == 2 ? (unsigned)BWIN : (((tau ? sm1 : sm0) != 0u) ? 0x7fffffffu : 0u);
                    if (!__all(((unsigned)(lim - key0) < span) && ((unsigned)(lim - (key0 + 63)) < span))) {
#pragma unroll
                        for (int h = 0; h < 2; ++h)
#pragma unroll
                            for (int i = 0; i < 4; ++i) {
                                const int k0_ = kb + 32 * h + i, k1_ = k0_ + 4;
                                sv[2 * h][i] = ((unsigned)(lim - k0_) < span) ? sv[2 * h][i] : NEG_INF; sv[2 * h + 1][i] = ((unsigned)(lim - k1_) < span) ? sv[2 * h + 1][i] : NEG_INF;
                            }
                    }
                    float mx = sv[0][0];
#pragma unroll
                    for (int tl = 0; tl < 4; ++tl)
#pragma unroll
                        for (int i = 0; i < 4; ++i) mx = fmaxf(mx, sv[tl][i]);
                    mx *= sc;
#if MK_PERMCHK
                    { const float mref = fmaxf(fmaxf(mx, __shfl_xor(mx, 16)), fmaxf(__shfl_xor(mx, 32), __shfl_xor(mx, 48))); const float mnew = rows4_max(mx); const float sref = (mx + __shfl_xor(mx, 16)) + (__shfl_xor(mx, 32) + __shfl_xor(mx, 48)); const float snew = rows4_sum(mx);
                      const bool fin = mref < 1e30f && fminf(fminf(mx, __shfl_xor(mx, 16)), fminf(__shfl_xor(mx, 32), __shfl_xor(mx, 48))) > -1e30f; const bool bad = !(mref == mnew) || (fin && !(fabsf(sref - snew) <= 1e-5f * fabsf(sref) + 1e-30f));
                      if (__any(bad) && lane == 0) atomicOr((unsigned*)(ws + WS_CTL) + 32768 + 64 * 20, 1u); }
#endif
                    mx = rows4_max(mx);
                    {
                        const float mn = (mx > m + G_THR) ? mx : m; const float alpha = __builtin_amdgcn_exp2f(m - mn); m = mn; l *= alpha;
#pragma unroll
                        for (int dt = 0; dt < 8; ++dt) O[dt] = O[dt] * alpha;
                    }
                    float ps = 0.f;
#pragma unroll
                    for (int i = 0; i < 16; ++i) { s[i] = __builtin_amdgcn_exp2f(__builtin_fmaf(sv[2 * (i >> 3) + ((i >> 2) & 1)][i & 3], sc, -m)); ps += s[i]; }
                    l += ps;
                    __builtin_amdgcn_sched_barrier(0);
#pragma unroll
                    for (int i = G_VPRE; i < 16; ++i) vf[i] = *(const LAS bf16x8*)(slot + (16 + 2 * (i & 7) + (i >> 3)) * 1024);
                    __builtin_amdgcn_sched_barrier(0);
#pragma unroll
                    for (int h = 0; h < 2; ++h) {
                        u32x4 pw; pw.x = cvt_pk_bf16(s[8 * h + 0], s[8 * h + 1]); pw.y = cvt_pk_bf16(s[8 * h + 2], s[8 * h + 3]); pw.z = cvt_pk_bf16(s[8 * h + 4], s[8 * h + 5]); pw.w = cvt_pk_bf16(s[8 * h + 6], s[8 * h + 7]);
                        const bf16x8 pf = __builtin_bit_cast(bf16x8, pw);
#pragma unroll
                        for (int dt = 0; dt < 8; ++dt) O[dt] = MFMA16(vf[h * 8 + dt], pf, O[dt]);
                    }
                }
            }
            LDS_WAIT(); g_lds_st(A_CTL + 4 * (16 + wave), (unsigned)idx + 1u);
            if (idx + 1 < nk) dnext = (unsigned)__builtin_amdgcn_readfirstlane((int)desc[idx + 1]);
            if (d & 4u) {
                if (kind != 1) {
                    const float lt = rows4_sum(l);
                    const float inv = lt > 0.f ? 1.0f / lt : 0.f;
                    if (kind == 0) { mfin = m; invc = inv; }
                    const float gs = (kind == 0 ? g_cmp : kind == 2 ? g_win : g_slc) * inv;
#pragma unroll
                    for (int dt = 0; dt < 8; ++dt) { Of[dt] = Of[dt] + O[dt] * gs; O[dt] = (f32x4){0.f, 0.f, 0.f, 0.f}; }
                    m = -1e30f; l = 0.f;
                } else {
                    LDS_WAIT();
                    int ln = lane; asm volatile("" : "+v"(ln));
                    bf16x8 q2[4];
                    { int tk2 = tw0 + ((ln & 15) >> 3); if (tk2 > T - 1) tk2 = T - 1;
                      const bf16* qrow2 = (const bf16*)(ws + WS_QBR) + ((size_t)b * T + tk2) * 2048 + (g * 8 + (ln & 7)) * 128 + (ln >> 4) * 8;
#pragma unroll
                      for (int kk = 0; kk < 4; ++kk) q2[kk] = *(const bf16x8*)(qrow2 + kk * 32); }
                    {
                        int tt = tw0 + (ln >> 5); if (tt > T - 1) tt = T - 1; const int cur = tt >> 6, l5 = ln & 31; const LAS float* ip = imp + (ln >> 5) * 136;
                        unsigned key[4];
#pragma unroll
                        for (int e = 0; e < 4; ++e) { const int j = l5 + 32 * e; const bool forced = (j == 0) | (j == cur) | (j == cur - 1); const unsigned v = forced ? 0x7f800000u : __float_as_uint(ip[j]);
                            key[e] = (j <= cur) ? ((v & ~0x7fu) | (unsigned)(127 - j)) : 0u; }
                        unsigned mw[4] = {0u, 0u, 0u, 0u};
#pragma unroll
                        for (int r = 0; r < NSEL; ++r) {
                            unsigned best = key[0] > key[1] ? key[0] : key[1]; { const unsigned b2 = key[2] > key[3] ? key[2] : key[3]; best = best > b2 ? best : b2; }
                            best = half32_umax(best);
                            if (best != 0u) {
                                const int j = 127 - (int)(best & 0x7fu);
#pragma unroll
                                for (int e = 0; e < 4; ++e) { if (key[e] == best) key[e] = 0u; if ((j >> 5) == e) mw[e] |= 1u << (j & 31); }
                            }
                        }
                        if (l5 == 0) {
#pragma unroll
                            for (int e = 0; e < 4; ++e) { selmask[(ln >> 5) * 4 + e] = mw[e]; __hip_atomic_fetch_or((LAS unsigned*)(lds + GX_CTL) + 4 + e, mw[e], __ATOMIC_RELAXED, __HIP_MEMORY_SCOPE_WORKGROUP); }
                        }
                    }
                    LDS_WAIT();
#pragma unroll
                    for (int e = 0; e < 8; ++e) smw[e] = (unsigned)__builtin_amdgcn_readfirstlane((int)selmask[e]);
                    if (ln == 0) __hip_atomic_fetch_add((LAS unsigned*)(lds + GX_CTL) + 8, 1u, __ATOMIC_RELAXED, __HIP_MEMORY_SCOPE_WORKGROUP);
                    if (wave == 0) {
                        g_wait_ge(A_CTL + 4 * 8, (unsigned)nact, A_CTL + 4 * 10);
                        const unsigned u0 = gctl[4], u1 = gctl[5], u2 = gctl[6], u3 = gctl[7];
                        const int base = nfix;
                        const int cnt = __popc(u0) + __popc(u1) + __popc(u2) + __popc(u3);
#pragma unroll
                        for (int e = 0; e < 2; ++e) {
                            const int j = ln + 64 * e; const unsigned w_ = (j >> 5) == 0 ? u0 : (j >> 5) == 1 ? u1 : (j >> 5) == 2 ? u2 : u3;
                            if ((w_ >> (j & 31)) & 1u) {
                                int r = __popc(w_ & ((1u << (j & 31)) - 1u));
                                if ((j >> 5) > 0) r += __popc(u0); if ((j >> 5) > 1) r += __popc(u1); if ((j >> 5) > 2) r += __popc(u2);
                                desc[base + r] = 3u | ((unsigned)(64 * j) << 8) | (r == cnt - 1 ? 4u : 0u);
                            }
                        }
                        LDS_WAIT();
                        if (ln == 0) { gctl[0] = (unsigned)(base + cnt); }
                        LDS_WAIT();
                        if (ln == 0) { gctl[9] = 1u; }
                        LDS_WAIT();
                    }
#pragma unroll
                    for (int kk = 0; kk < 4; ++kk) q[kk] = q2[kk];
                }
            }
        }
        if (tok_ok && !crip) {
            int ln = lane; asm volatile("" : "+v"(ln));
            int tk2 = tw0 + ((ln & 15) >> 3); if (tk2 > T - 1) tk2 = T - 1;
            bf16* orow = (bf16*)(ws + WS_OB) + ((size_t)b * T + tk2) * 2048 + (g * 8 + (ln & 7)) * 128 + 4 * (ln >> 4);
#pragma unroll
            for (int dt = 0; dt < 8; ++dt) { u32x2 p; p.x = cvt_pk_bf16(Of[dt][0], Of[dt][1]); p.y = cvt_pk_bf16(Of[dt][2], Of[dt][3]); *(u32x2*)(orow + 16 * dt) = p; }
        }
    }
    asm volatile("s_waitcnt vmcnt(0) lgkmcnt(0)" ::: "memory"); __builtin_amdgcn_s_barrier(); asm volatile("" ::: "memory");
}

#ifndef MK_CHECK
#define MK_CHECK 0
#define MK_CHECK_BIT 0
#define MK_CHECK_TOTAL 8192
#endif
constexpr int CW_DBG = 32768;
__device__ __forceinline__ float bf2f(bf16 v) { return __uint_as_float(((unsigned)v) << 16); }
__device__ __forceinline__ unsigned hash_u(unsigned x) { x ^= x >> 16; x *= 0x7feb352du; x ^= x >> 15; x *= 0x846ca68bu; x ^= x >> 16; return x; }
__device__ __forceinline__ float dot_bf(const bf16* a, const bf16* b, int n, int lane) { float s = 0.f; for (int k = lane; k < n; k += 64) s += bf2f(a[k]) * bf2f(b[k]); return wave_sum(s); }
__device__ __forceinline__ void dbg_flag(unsigned* ctl, int bit, bool bad, int lane) { if (bad && lane == 0) atomicAdd(ctl + CW_DBG + 64 * bit, 1u); }
__device__ __forceinline__ void dbg_after_p4(unsigned char* ws, unsigned* ctl, const int* pos, int gw, int NGW, int lane) {
    const bf16* XN = (const bf16*)(ws + WS_XN); const bf16* WIN = (const bf16*)(ws + WS_WIN);
    for (int s = gw; s < 8192; s += NGW) {
        const unsigned h = hash_u((unsigned)s * 2654435761u + 12345u); const int row = (int)(h % M); const unsigned h2 = hash_u(h + 77u);
        const int b = row / T, t = row % T;
        {
            const int col = (int)(h2 % 8192u), which = col >> 12, cc = col & 4095;
            const float d = dot_bf(XN + (size_t)row * DM, WIN + (size_t)(6144 + which * 4096 + cc) * DM, DM, lane);
            const float ref = 1.f / (1.f + expf(-d)); const float got = bf2f(((const bf16*)(ws + (which ? WS_SGB : WS_SGA)))[(size_t)row * DM + cc]);
            const bool badg = !(fabsf(ref - got) < 0.02f);
            dbg_flag(ctl, 0, badg, lane);
            dbg_flag(ctl, 7, !(got >= -0.01f && got <= 1.01f), lane);
            if (lane == 0) atomicMax(ctl + CW_DBG + 64 * 12, __float_as_uint(fabsf(ref - got)));
            if (badg && lane == 0) { const float xv = bf2f(XN[(size_t)row * DM + cc]); unsigned hm = 0; if (fabsf(got - d) < 0.05f) hm |= 1; if (got == xv) hm |= 2; if (fabsf(got) < 1e-6f) hm |= 4; if (got >= 0.f && got <= 1.f) hm |= 8; if (got == 65536.f) hm |= 16; if (which) hm |= 32; atomicAnd(ctl + CW_DBG + 64 * 13, hm); atomicOr(ctl + CW_DBG + 64 * 14, hm); }
            if (badg && lane == 0) { const unsigned prop = (unsigned)(col & 255) | ((unsigned)(row & 255) << 8) | ((unsigned)((col >> 8) & 31) << 16) | ((unsigned)(row >> 8) << 21); atomicAnd(ctl + CW_DBG + 64 * 10, prop); atomicOr(ctl + CW_DBG + 64 * 11, prop); }
        }
        {
            const int cc = (int)(h2 % 256u);
            float d = dot_bf(XN + (size_t)row * DM, WIN + (size_t)(4608 + cc) * DM, DM, lane); float got = bf2f(((const bf16*)(ws + WS_KC))[(size_t)row * 256 + cc]);
            bool bad = !(fabsf(d - got) < 0.03f + 0.02f * fabsf(d));
            d = dot_bf(XN + (size_t)row * DM, WIN + (size_t)(4864 + cc) * DM, DM, lane); got = bf2f(((const bf16*)(ws + WS_VC))[(size_t)row * 256 + cc]);
            bad |= !(fabsf(d - got) < 0.03f + 0.02f * fabsf(d));
            d = dot_bf(XN + (size_t)row * DM, WIN + (size_t)(2304 + cc) * DM, DM, lane); got = bf2f(((const bf16*)(ws + WS_VAT))[((size_t)b * 256 + cc) * T + t]);
            bad |= !(fabsf(d - got) < 0.03f + 0.02f * fabsf(d));
            d = dot_bf(XN + (size_t)row * DM, WIN + (size_t)(5376 + cc) * DM, DM, lane); got = bf2f(((const bf16*)(ws + WS_VST))[((size_t)b * 256 + cc) * T + t]);
            bad |= !(fabsf(d - got) < 0.03f + 0.02f * fabsf(d));
            d = dot_bf(XN + (size_t)row * DM, WIN + (size_t)(5888 + cc) * DM, DM, lane); got = bf2f(((const bf16*)(ws + WS_VWT))[((size_t)b * 256 + cc) * T + t]);
            bad |= !(fabsf(d - got) < 0.03f + 0.02f * fabsf(d));
            const int hc = (int)(h2 % 2048u);
            d = dot_bf(XN + (size_t)row * DM, WIN + win_row_off(2560 + hc), DM, lane); got = bf2f(((const bf16*)(ws + WS_QB0))[(size_t)row * 2048 + hc]);
            bad |= !(fabsf(d - got) < 0.03f + 0.02f * fabsf(d));
            dbg_flag(ctl, 1, bad, lane);
        }
        {
            const int g = (int)(h2 & 1u), p = (int)((h2 >> 1) & 127u), q = p >> 3, e = p & 7, fi = 4 * q + (e & 3);
            const float x1 = dot_bf(XN + (size_t)row * DM, WIN + win_row_off(5120 + g * 128 + fi), DM, lane), x2 = dot_bf(XN + (size_t)row * DM, WIN + win_row_off(5120 + g * 128 + 64 + fi), DM, lane);
            double inv = 1.0; for (int i = 0; i < fi; ++i) inv *= 0.8659643233600653524; const double ang = (double)pos[row] * inv; const float cs = (float)cos(ang), sn = (float)sin(ang);
            const float ref = e < 4 ? x1 * cs - x2 * sn : x2 * cs + x1 * sn; const float got = bf2f(((const bf16*)(ws + WS_KS))[(size_t)row * 256 + g * 128 + p]);
            bool bad = !(fabsf(ref - got) < 0.03f + 0.02f * fabsf(ref));
            const int kvh = (int)((h2 >> 8) & 3u), p6 = (int)((h2 >> 10) & 63u), q6 = p6 >> 3, e6 = p6 & 7, f6 = 4 * q6 + (e6 & 3);
            const float y1 = dot_bf(XN + (size_t)row * DM, WIN + win_row_off(2048 + kvh * 64 + f6), DM, lane), y2 = dot_bf(XN + (size_t)row * DM, WIN + win_row_off(2048 + kvh * 64 + 32 + f6), DM, lane);
            double inv6 = 1.0; for (int i = 0; i < f6; ++i) inv6 *= 0.7498942093324558273; const double a6 = (double)pos[row] * inv6; const float c6 = (float)cos(a6), s6 = (float)sin(a6);
            const float r6 = e6 < 4 ? y1 * c6 - y2 * s6 : y2 * c6 + y1 * s6; const float g6 = bf2f(((const bf16*)(ws + WS_KA))[(size_t)row * 256 + kvh * 64 + p6]);
            bad |= !(fabsf(r6 - g6) < 0.03f + 0.02f * fabsf(r6));
            dbg_flag(ctl, 2, bad, lane);
        }
    }
}
__device__ __forceinline__ void dbg_after_p5(unsigned char* ws, unsigned* ctl, const float* sinks, const float* pe_k, const float* pe_v, const float* w1k, const float* w1v, int gw, int NGW, int lane) {
    for (int s = gw; s < 4096; s += NGW) {
        const unsigned h = hash_u((unsigned)s * 2654435761u + 999u); const int row = (int)(h % M); const int b = row / T, t = row % T; const int head = (int)(hash_u(h + 5u) % 32u), kvh = head >> 3;
        {
            const bf16* q = (const bf16*)(ws + WS_QA) + (size_t)row * 2048 + head * 64; const int lo = t - 127 < 0 ? 0 : t - 127;
            float sc[2];
#pragma unroll
            for (int i = 0; i < 2; ++i) { const int key = lo + lane + 64 * i; float d = -INFINITY; if (key <= t) { const bf16* k = (const bf16*)(ws + WS_KA) + ((size_t)b * T + key) * 256 + kvh * 64; d = 0.f; for (int p = 0; p < 64; ++p) d += bf2f(q[p]) * bf2f(k[p]); d *= 0.125f; } sc[i] = d; }
            float m = fmaxf(fmaxf(sc[0], sc[1]), sinks[head]);
#pragma unroll
            for (int o = 1; o < 64; o <<= 1) m = fmaxf(m, __shfl_xor(m, o));
            const float e0 = expf(sc[0] - m), e1 = expf(sc[1] - m); const float den = wave_sum(e0 + e1) + expf(sinks[head] - m);
            float o = 0.f; const bf16* v = (const bf16*)(ws + WS_VAT) + ((size_t)b * 256 + kvh * 64 + lane) * T;
            for (int kk = 0; kk < 128; ++kk) { const int key = lo + kk; const float p = __shfl(kk < 64 ? e0 : e1, kk & 63); if (key <= t) o += p * bf2f(v[key]); }
            o /= den; const float got = bf2f(((const bf16*)(ws + WS_OA))[(size_t)row * 2048 + head * 64 + lane]);
            const bool bad = !(fabsf(o - got) < 0.02f + 0.03f * fabsf(o));
            dbg_flag(ctl, 3, __any(bad), lane);
        }
    }
    for (int s = gw; s < 512; s += NGW) {
        const unsigned h = hash_u((unsigned)s * 2654435761u + 4242u); const int x = h & 1, b = (h >> 1) & 1, g = (h >> 2) & 1, c = (int)((h >> 3) % 511u), dout = (int)((h >> 12) & 127u);
        const bf16* src = (const bf16*)(ws + (x ? WS_VC : WS_KC)) + (size_t)b * T * 256 + g * 128; const bf16* w1 = (const bf16*)(ws + (x ? WS_CV1 : WS_CK1)); const bf16* w2 = (const bf16*)(ws + (x ? WS_CV2 : WS_CK2));
        const float* pe = x ? pe_v : pe_k; const float* w1f = x ? w1v : w1k;
        float acc = 0.f;
        for (int hid = 0; hid < 128; ++hid) {
            float d = 0.f;
            for (int k = lane; k < 4096; k += 64) { const int l = k >> 7, dd = k & 127; d += bf2f(src[(size_t)(16 * c + l) * 256 + dd]) * bf2f(w1[(size_t)hid * 4096 + k]) + pe[k] * w1f[(size_t)k * 128 + hid]; }
            d = wave_sum(d);
            const float u = 0.7978845608028654f * (d + 0.044715f * d * d * d); const float ge = 0.5f * d * (1.f + tanhf(u));
            acc += ge * bf2f(w2[(size_t)dout * 128 + hid]);
        }
        const float got = x ? bf2f(((const bf16*)(ws + WS_VCMPT))[((size_t)(b * 2 + g) * 128 + dout) * NCP + c]) : bf2f(((const bf16*)(ws + WS_KCMP))[((size_t)(b * 2 + g) * NCP + c) * 128 + dout]);
        dbg_flag(ctl, 4, !(fabsf(acc - got) < 0.03f + 0.03f * fabsf(acc)), lane);
    }
}
__device__ __forceinline__ void dbg_after_p7(unsigned char* ws, unsigned* ctl, int gw, int NGW, int lane) {
    for (int s = gw; s < 8192; s += NGW) {
        const unsigned h = hash_u((unsigned)s * 2654435761u + 31337u); const int row = (int)(h % M), col = (int)(hash_u(h + 9u) % 4096u);
        const float ya = dot_bf((const bf16*)(ws + WS_OA) + (size_t)row * 2048, (const bf16*)(ws + WS_WOA) + (size_t)col * 2048, 2048, lane);
        const float yb = dot_bf((const bf16*)(ws + WS_OB) + (size_t)row * 2048, (const bf16*)(ws + WS_WOB) + (size_t)col * 2048, 2048, lane);
        const float ref = bf2f(((const bf16*)(ws + WS_SGA))[(size_t)row * DM + col]) * ya + bf2f(((const bf16*)(ws + WS_SGB))[(size_t)row * DM + col]) * yb;
        const float got = bf2f(((const bf16*)(ws + WS_XN))[(size_t)row * DM + col]);
        dbg_flag(ctl, 5, !(fabsf(ref - got) < 0.01f + 0.03f * fabsf(ref)), lane);
    }
}

constexpr int RING_BYTES = 131072, MISC_OFF = RING_BYTES, LDS_BYTES = 147456;
struct Args { const void* in[27]; float* out; unsigned char* ws; int ph_lo, ph_hi, qoff, pad; };
enum { I_X = 0, I_P, I_POS, I_FFN1_NORM, I_FFN1_WG, I_FFN1_WU, I_FFN1_WD, I_MIX_NORM, I_W_IN, I_SINKS, I_PE_K, I_CK1, I_CK2, I_PE_V, I_CV1, I_CV2, I_WOA, I_WOB, I_WO,
       I_FFN2_NORM, I_FFN2_WG, I_FFN2_WU, I_FFN2_WD, I_PLE_NORM, I_WPG, I_WPP, I_FINAL_NORM };

__global__ void __launch_bounds__(NWAVES * 64, 2) mk_fwd(Args args) {
    extern __shared__ __attribute__((aligned(16))) unsigned char lds_raw[];
    LAS unsigned char* lds = (LAS unsigned char*)lds_raw;
    volatile LAS unsigned* MISC = (volatile LAS unsigned*)(lds + MISC_OFF);
    const int tid = threadIdx.x, lane = tid & 63, wave = __builtin_amdgcn_readfirstlane(tid >> 6);
    const int G = gridDim.x, bx = blockIdx.x;
    const int vcu = (G % 8 == 0) ? (bx % 8) * (G / 8) + bx / 8 : bx;
    const int gw = vcu * NWAVES + wave, NGW = G * NWAVES;
    unsigned char* ws = args.ws;
    unsigned* ctl = (unsigned*)(ws + WS_CTL);
    float* out = args.out;
    for (int u = tid; u < (LDS_BYTES - MISC_OFF) / 4; u += NWAVES * 64) ((LAS unsigned*)(lds + MISC_OFF))[u] = 0u;
    __syncthreads();
    const int lo = args.ph_lo, hi = args.ph_hi;
    XcdBarrier bar; bar.bar = ctl + CW_BAR; bar.x = 0; bar.st = nullptr;
    if (hi - lo > 1) bar = xcd_barrier_post(ctl + CW_BAR, MISC + 8);
#ifndef PH_MASK
#define PH_MASK 0x7fff
#endif
#define IN(k) (((PH_MASK >> (k)) & 1) && lo <= (k) && (k) < hi)
#define SEAM(k) do { if (IN(k) && IN((k) + 1)) xcd_barrier(bar); } while (0)

    if (IN(0)) {
        if (MK_CHECK && bx == 0 && tid == 0) { ctl[CW_DBG + 64 * 10] = 0xffffffffu; ctl[CW_DBG + 64 * 13] = 0xffffffffu; }
        for (int mi = 0; mi < 14; ++mi) {
            if (mi >= 3 && mi <= 8) continue;
            const float* W; bf16* dst; int K, N, map;
            switch (mi) {
                case 0: W = (const float*)args.in[I_FFN1_WG]; dst = (bf16*)(ws + WS_WFF); K = DM; N = DFF; map = MAP_GATE; break;
                case 1: W = (const float*)args.in[I_FFN1_WU]; dst = (bf16*)(ws + WS_WFF); K = DM; N = DFF; map = MAP_UP; break;
                case 2: W = (const float*)args.in[I_FFN1_WD]; dst = (bf16*)(ws + WS_WFD); K = DFF; N = DM; map = MAP_BLK; break;
                case 3: W = (const float*)args.in[I_W_IN]; dst = (bf16*)(ws + WS_WIN); K = DM; N = DIN; map = MAP_WIN; break;
                case 4: W = (const float*)args.in[I_WOA]; dst = (bf16*)(ws + WS_WOA); K = 2048; N = DM; map = MAP_ID; break;
                case 5: W = (const float*)args.in[I_WOB]; dst = (bf16*)(ws + WS_WOB); K = 2048; N = DM; map = MAP_ID; break;
                case 6: W = (const float*)args.in[I_WO]; dst = (bf16*)(ws + WS_WO); K = DM; N = DM; map = MAP_ID; break;
                case 7: W = (const float*)args.in[I_WPG]; dst = (bf16*)(ws + WS_WPG); K = DM; N = DM; map = MAP_ID; break;
                case 8: W = (const float*)args.in[I_WPP]; dst = (bf16*)(ws + WS_WPP); K = PLE; N = DM; map = MAP_ID; break;
                case 9: W = (const float*)args.in[I_CK1]; dst = (bf16*)(ws + WS_CK1); K = 4096; N = 128; map = MAP_ID; break;
                case 10: W = (const float*)args.in[I_CV1]; dst = (bf16*)(ws + WS_CV1); K = 4096; N = 128; map = MAP_ID; break;
                case 11: W = (const float*)args.in[I_CK2]; dst = (bf16*)(ws + WS_CK2); K = 128; N = 128; map = MAP_ID; break;
                case 12: W = (const float*)args.in[I_CV2]; dst = (bf16*)(ws + WS_CV2); K = 128; N = 128; map = MAP_ID; break;
                default: W = nullptr; dst = nullptr; K = 64; N = 0; map = MAP_ID; break;
            }
            const int ni = items_of(K, N);
            int it = gw;
            for (; it + NGW < ni; it += 2 * NGW) tr_item2(W, K, N, dst, map, it, it + NGW, lane);
            if (it < ni) tr_item(W, K, N, dst, map, it, lane);
        }
        for (int m = gw; m < M; m += NGW) norm_row_bf16((const float*)args.in[I_X] + (size_t)m * DM, (const float*)args.in[I_FFN1_NORM], (bf16*)(ws + WS_XN) + (size_t)m * DM, lane);
        { const f32x4* ps = (const f32x4*)args.in[I_P]; u32x2* pd = (u32x2*)(ws + WS_P16);
          for (int i = gw * 64 + lane; i < M * PLE / 4; i += NGW * 64) { const f32x4 v = ps[i]; u32x2 o; o.x = cvt_pk_bf16(v.x, v.y); o.y = cvt_pk_bf16(v.z, v.w); pd[i] = o; } }
        { const int* pos = (const int*)args.in[I_POS]; f32x2* r64 = (f32x2*)(ws + WS_ROPE64); f32x2* r128 = (f32x2*)(ws + WS_ROPE128);
          for (int i = gw * 64 + lane; i < M * 96; i += NGW * 64) {
              const int m = i / 96, e = i % 96; const int f = e < 32 ? e : e - 32; const double base = e < 32 ? 0.7498942093324558273 : 0.8659643233600653524;
              double inv = 1.0; double bp = base; int ff = f;
#pragma unroll
              for (int bit = 0; bit < 6; ++bit) { if (ff & 1) inv *= bp; bp *= bp; ff >>= 1; }
              float c, s; sincos_d((double)pos[m] * inv, c, s);
              if (e < 32) r64[(size_t)m * 32 + f] = (f32x2){c, s}; else r128[(size_t)m * 64 + f] = (f32x2){c, s}; } }
        if (gw < 64) { const int x = gw >> 5, kc = (gw >> 1) & 15, hh = gw & 1; const float* pe = (const float*)args.in[x ? I_PE_V : I_PE_K]; const float* w1 = (const float*)args.in[x ? I_CV1 : I_CK1];
            const int hid = hh * 64 + lane; float s = 0.f;
            for (int k = kc * 256; k < kc * 256 + 256; ++k) s += pe[k] * w1[(size_t)k * 128 + hid];
            ((float*)(ws + WS_CBP))[(x * 16 + kc) * 128 + hid] = s; }
    }
    SEAM(0);
    if (IN(1)) {
        pg8::Gemm g{(const bf16*)(ws + WS_XN), (const bf16*)(ws + WS_WFF), nullptr, nullptr, DM, 0, 0}; pg8::StaticOrder S; S.init(M, 2 * DFF, G, bx);
        pg8::EpiFF E{(bf16*)(ws + WS_ACT)};
        pg8::gemm_phase<pg8::EpiFF, pg8::StaticOrder>(lds, g, S, E);
        { const int nun = (M / 256) * (2 * DFF / 256), nfull = nun - (nun / G) * G; const bool split = nfull > 0 && nfull < G;
          const int nb = split ? G - nfull : G, rb = split ? bx - nfull : bx;
          if (rb >= 0) { const int ni = items_of(DM, DIN); for (int it = rb * NWAVES + wave; it < ni; it += nb * NWAVES) tr_item((const float*)args.in[I_W_IN], DM, DIN, (bf16*)(ws + WS_WIN), MAP_WIN, it, lane); } }
    }
    SEAM(1);
    if (IN(2)) {
        pg8::Gemm g{(const bf16*)(ws + WS_ACT), (const bf16*)(ws + WS_WFD), nullptr, nullptr, DFF, 1, 1}; pg8::StaticOrder S; S.init(M, DM, G, bx, 2);
        pg8::EpiRes E{(const float*)args.in[I_X], out, 0.5f};
        pg8::gemm_phase<pg8::EpiRes, pg8::StaticOrder>(lds, g, S, E);
    }
    SEAM(2);
    if (IN(3)) {
        if (MK_CHECK) { u32x4* sp = (u32x4*)(ws + WS_SGA); for (size_t i = (size_t)gw * 64 + lane; i < (size_t)2 * M * DM * 2 / 16; i += (size_t)NGW * 64) sp[i] = (u32x4){0x47804780u, 0x47804780u, 0x47804780u, 0x47804780u}; }
        for (int m = gw; m < M; m += NGW) norm_row_bf16(out + (size_t)m * DM, (const float*)args.in[I_MIX_NORM], (bf16*)(ws + WS_XN) + (size_t)m * DM, lane);
    }
    SEAM(3);
    if (IN(4)) {
        pg8::Gemm g{(const bf16*)(ws + WS_XN), (const bf16*)(ws + WS_WIN), nullptr, nullptr, DM, 0, 0}; pg8::StaticOrder S; S.init(M, DIN_S, G, bx);
        pg8::EpiIn E{ws};
        pg8::gemm_phase<pg8::EpiIn, pg8::StaticOrder>(lds, g, S, E);
    }
    SEAM(4);
    if (MK_CHECK && lo == 104) dbg_after_p4(ws, ctl, (const int*)args.in[I_POS], gw, NGW, lane);
    if (IN(5)) {
        for (int task = bx; task < 256; task += G) compress_task(ws, lds, task, wave, lane);
        if (wave >= 4) {
            const int gw4 = vcu * 4 + (wave - 4), NGW4 = G * 4;
            for (int mi = 0; mi < 3; ++mi) {
                const float* W = (const float*)args.in[mi == 0 ? I_FFN2_WG : mi == 1 ? I_FFN2_WU : I_FFN2_WD]; bf16* dst = (bf16*)(ws + (mi == 2 ? WS_WFD : WS_WFF));
                const int K = mi == 2 ? DFF : DM, N = mi == 2 ? DM : DFF, map = mi == 0 ? MAP_GATE : mi == 1 ? MAP_UP : MAP_BLK;
                const int ni = items_of(K, N);
                int it = gw4;
                for (; it + NGW4 < ni; it += 2 * NGW4) tr_item2(W, K, N, dst, map, it, it + NGW4, lane);
                if (it < ni) tr_item(W, K, N, dst, map, it, lane);
            }
            for (int mi = 0; mi < 5; ++mi) {
                const float* W = (const float*)args.in[mi == 0 ? I_WOA : mi == 1 ? I_WOB : mi == 2 ? I_WO : mi == 3 ? I_WPG : I_WPP];
                bf16* dst = (bf16*)(ws + (mi == 0 ? WS_WOA : mi == 1 ? WS_WOB : mi == 2 ? WS_WO : mi == 3 ? WS_WPG : WS_WPP));
                const int K = mi < 2 ? 2048 : mi == 4 ? PLE : DM, N = DM;
                const int ni = items_of(K, N);
                int it = gw4;
                for (; it + NGW4 < ni; it += 2 * NGW4) tr_item2(W, K, N, dst, MAP_ID, it, it + NGW4, lane);
                if (it < ni) tr_item(W, K, N, dst, MAP_ID, it, lane);
            }
        }
        const int xq = bx & 7; unsigned* qh = ctl + CW_Q5 + args.qoff + 64 * xq;
        for (;;) {
            int id = 0; if (lane == 0) id = (int)atomicAdd(qh, 1u); id = __builtin_amdgcn_readfirstlane(id);
            if (id >= 128 + 2048) break;
            if (id < 128) gates_task(ws, xq * 128 + id, lane);
            else { const int k = id - 128; mixer_a_task4(ws, (const float*)args.in[I_SINKS], xq >> 2, xq & 3, 2047 - k, lane); }
        }
    }
    SEAM(5);
    if (IN(6)) {
        const int xq = bx & 7; unsigned* qh = ctl + CW_Q6 + args.qoff + 64 * xq;
        volatile LAS unsigned* gctl = (volatile LAS unsigned*)(lds + GX_CTL);
        unsigned nxt = 0u; if (tid == 0) nxt = atomicAdd(qh, 1u);
        for (;;) {
            if (tid == 0) gctl[1] = nxt;
            LDS_WAIT(); __builtin_amdgcn_s_barrier(); asm volatile("" ::: "memory");
            const int id = __builtin_amdgcn_readfirstlane((int)gctl[1]);
            __builtin_amdgcn_s_barrier(); asm volatile("" ::: "memory");
            if (id >= (G_NGROUP + 1) / 2) break;
            if (tid == 0) nxt = atomicAdd(qh, 1u);
            const int tg = 2 * ((G_NGROUP + 1) / 2 - 1 - id) + (xq & 1);
            if (tg < G_NGROUP) nsa_group_task(ws, lds, xq >> 2, (xq >> 1) & 1, tg, wave, lane, MK_P6CRIP ? (args.qoff ? MK_P6CRIP : 0) : 0);
        }
    }
    SEAM(6);
    if (IN(7)) {
        if (MK_CHECK) dbg_after_p5(ws, ctl, (const float*)args.in[I_SINKS], (const float*)args.in[I_PE_K], (const float*)args.in[I_PE_V], (const float*)args.in[I_CK1], (const float*)args.in[I_CV1], gw, NGW, lane);
        pg8::Gemm g{(const bf16*)(ws + WS_OA), (const bf16*)(ws + WS_WOA), (const bf16*)(ws + WS_OB), (const bf16*)(ws + WS_WOB), 2048, 0, 0}; pg8::PairOrder S; S.init(M, DM, G, bx);
        pg8::EpiMerge E{(const bf16*)(ws + WS_SGA), (const bf16*)(ws + WS_SGB), (bf16*)(ws + WS_XN)};
        pg8::gemm_phase<pg8::EpiMerge, pg8::PairOrder>(lds, g, S, E);
    }
    SEAM(7);
    if (IN(8)) {
        if (MK_CHECK) dbg_after_p7(ws, ctl, gw, NGW, lane);
        pg8::Gemm g{(const bf16*)(ws + WS_XN), (const bf16*)(ws + WS_WO), nullptr, nullptr, DM, 0, 0}; pg8::StaticOrder S; S.init(M, DM, G, bx);
        pg8::EpiRes E{out, out, 1.0f};
        pg8::gemm_phase<pg8::EpiRes, pg8::StaticOrder>(lds, g, S, E);
    }
    SEAM(8);
    if (IN(9)) {
        for (int m = gw; m < M; m += NGW) norm_row_bf16(out + (size_t)m * DM, (const float*)args.in[I_FFN2_NORM], (bf16*)(ws + WS_XN) + (size_t)m * DM, lane);
    }
    SEAM(9);
    if (IN(10)) {
        pg8::Gemm g{(const bf16*)(ws + WS_XN), (const bf16*)(ws + WS_WFF), nullptr, nullptr, DM, 0, 0}; pg8::StaticOrder S; S.init(M, 2 * DFF, G, bx);
        pg8::EpiFF E{(bf16*)(ws + WS_ACT)};
        pg8::gemm_phase<pg8::EpiFF, pg8::StaticOrder>(lds, g, S, E);
        const int nfull = (M / 256) * (2 * DFF / 256) - ((M / 256) * (2 * DFF / 256) / G) * G;
        { const bool split = nfull > 0 && nfull < G; const int G2 = split ? G - nfull : G, c2 = split ? bx - nfull : bx;
          if (c2 >= 0) { pg8::Gemm g2{(const bf16*)(ws + WS_P16), (const bf16*)(ws + WS_WPP), nullptr, nullptr, PLE, 0, 0}; pg8::StaticOrder S2; S2.init(M, DM, G2, c2);
              pg8::EpiF32 E2{(float*)(ws + WS_PP)};
              pg8::gemm_phase<pg8::EpiF32, pg8::StaticOrder>(lds, g2, S2, E2); } }
    }
    SEAM(10);
    if (IN(11)) {
        pg8::Gemm g{(const bf16*)(ws + WS_ACT), (const bf16*)(ws + WS_WFD), nullptr, nullptr, DFF, 1, 1}; pg8::StaticOrder S; S.init(M, DM, G, bx, 2);
        pg8::EpiRes E{out, out, 0.5f};
        pg8::gemm_phase<pg8::EpiRes, pg8::StaticOrder>(lds, g, S, E);
    }
    SEAM(11);
    if (IN(12)) {
        for (int m = gw; m < M; m += NGW) norm_row_bf16(out + (size_t)m * DM, (const float*)args.in[I_PLE_NORM], (bf16*)(ws + WS_XN) + (size_t)m * DM, lane);
    }
    SEAM(12);
    if (IN(13)) {
        pg8::Gemm g{(const bf16*)(ws + WS_XN), (const bf16*)(ws + WS_WPG), nullptr, nullptr, DM, 0, 0}; pg8::StaticOrder S; S.init(M, DM, G, bx);
        pg8::EpiPle E{(const float*)(ws + WS_PP), out};
        pg8::gemm_phase<pg8::EpiPle, pg8::StaticOrder>(lds, g, S, E);
    }
    SEAM(13);
    if (IN(14)) {
        for (int m = gw; m < M; m += NGW) norm_row_f32_inplace(out + (size_t)m * DM, (const float*)args.in[I_FINAL_NORM], lane);
#if MK_PERMCHK
        if (bx == 0 && tid == 0) { const unsigned f = __hip_atomic_load(ctl + CW_DBG + 64 * 20, __ATOMIC_RELAXED, __HIP_MEMORY_SCOPE_AGENT); VM_WAIT(); if (f) out[0] = 5000.f; }
#endif
        if (MK_CHECK && bx == 0 && tid == 0) { const unsigned pa = __hip_atomic_load(ctl + CW_DBG + 64 * 10, __ATOMIC_RELAXED, __HIP_MEMORY_SCOPE_AGENT), po = __hip_atomic_load(ctl + CW_DBG + 64 * 11, __ATOMIC_RELAXED, __HIP_MEMORY_SCOPE_AGENT); VM_WAIT(); (void)pa; (void)po; const unsigned ha = __hip_atomic_load(ctl + CW_DBG + 64 * 13, __ATOMIC_RELAXED, __HIP_MEMORY_SCOPE_AGENT), ho = __hip_atomic_load(ctl + CW_DBG + 64 * 14, __ATOMIC_RELAXED, __HIP_MEMORY_SCOPE_AGENT); (void)ho; (void)ha; const unsigned bad = __hip_atomic_load(ctl + CW_DBG + 64 * 7, __ATOMIC_RELAXED, __HIP_MEMORY_SCOPE_AGENT); out[0] = 1000.f * (1.f + 63.f * (float)bad / 8192.f); }
    }
#undef IN
#undef SEAM
}

extern "C" void kernel_launch(void* const* d_in, const int* in_sizes, int n_in, void* d_out, int out_size, void* d_ws, size_t ws_size, hipStream_t stream) {
    static int grid = 0;
    if (grid == 0) {
        if (n_in != 27 || out_size != M * DM || ws_size < WS_END) { fprintf(stderr, "kernel_launch: unexpected shapes (n_in %d, out %d, ws %zu, need %zu); nothing launched\n", n_in, out_size, ws_size, (size_t)WS_END); grid = -1; return; }
        int dev = 0, cus = 0, per_cu = 0;
        if (hipGetDevice(&dev) != hipSuccess || hipDeviceGetAttribute(&cus, hipDeviceAttributeMultiprocessorCount, dev) != hipSuccess) { grid = -1; return; }
        if (hipFuncSetAttribute((const void*)mk_fwd, hipFuncAttributeMaxDynamicSharedMemorySize, LDS_BYTES) != hipSuccess) { fprintf(stderr, "kernel_launch: hipFuncSetAttribute failed\n"); grid = -1; return; }
        if (hipOccupancyMaxActiveBlocksPerMultiprocessor(&per_cu, (const void*)mk_fwd, NWAVES * 64, LDS_BYTES) != hipSuccess || per_cu < 1) fprintf(stderr, "kernel_launch: occupancy query reports %d blocks per CU\n", per_cu);
        (void)hipGetLastError();
        grid = cus;
    }
    if (grid < 0) return;
    if (hipMemsetAsync((char*)d_ws + WS_CTL, 0, CTL_BYTES, stream) != hipSuccess) return;
    Args a{};
    for (int i = 0; i < 27; ++i) a.in[i] = d_in[i];
    a.out = (float*)d_out; a.ws = (unsigned char*)d_ws;
#if MK_ONE_LAUNCH
    a.ph_lo = 0; a.ph_hi = NPHASE;
    hipLaunchKernelGGL(mk_fwd, dim3(grid), dim3(NWAVES * 64), LDS_BYTES, stream, a);
#else
    for (int p = 0; p < NPHASE; ++p) { a.ph_lo = p; a.ph_hi = p + 1; a.qoff = 0; hipLaunchKernelGGL(mk_fwd, dim3(grid), dim3(NWAVES * 64), LDS_BYTES, stream, a);
        if ((MK_DUP >> p) & 1) { a.qoff = 2048; hipLaunchKernelGGL(mk_fwd, dim3(grid), dim3(NWAVES * 64), LDS_BYTES, stream, a); a.qoff = 0; }
        if (MK_CHECK && p == 4) { a.ph_lo = 104; a.ph_hi = 105; hipLaunchKernelGGL(mk_fwd, dim3(grid), dim3(NWAVES * 64), LDS_BYTES, stream, a); } }
#endif
}
```

```cpp
#include <hip/hip_runtime.h>
#include <stdio.h>
#include <stdint.h>

#ifndef MK_DBG
#define MK_DBG 0
#endif
#ifndef MK_DBG2
#define MK_DBG2 0
#endif
#ifndef MK_SKIP
#define MK_SKIP 0
#endif
#ifndef MK_P6CRIP
#define MK_P6CRIP 0
#endif
#ifndef MK_DUP
#define MK_DUP 0
#endif
#ifndef MK_PERMCHK
#define MK_PERMCHK 0
#endif
#ifndef MK_ONE_LAUNCH
#define MK_ONE_LAUNCH 1
#endif

#define GAS __attribute__((address_space(1)))
#define LAS __attribute__((address_space(3)))
typedef unsigned short bf16;
typedef short bf16x8 __attribute__((ext_vector_type(8)));
typedef float f32x4 __attribute__((ext_vector_type(4)));
typedef float f32x2 __attribute__((ext_vector_type(2)));
typedef unsigned u32x4 __attribute__((ext_vector_type(4)));
typedef unsigned u32x2 __attribute__((ext_vector_type(2)));

constexpr int BATCH = 2, T = 8192, M = BATCH * T, DM = 4096, DFF = 11008, PLE = 256;
constexpr int AH = 32, AKV = 4, AD = 64, AWIN = 128;
constexpr int BH = 16, BG = 2, BD = 128, BWIN = 512;
constexpr int NC = 511, NCP = 512, NS = 128, NSEL = 16;
constexpr int DIN = 14384, DIN_S = 14336;
constexpr float EPS = 1e-6f;
constexpr float LOG2E = 1.4426950408889634f;
constexpr int NWAVES = 8;
constexpr int NPHASE = 15;

constexpr size_t al256(size_t x) { return (x + 255) & ~(size_t)255; }
constexpr size_t WS_CTL = 0, CTL_BYTES = 1u << 20;
constexpr size_t WS_ROPE64 = WS_CTL + CTL_BYTES;
constexpr size_t WS_ROPE128 = WS_ROPE64 + (size_t)M * 32 * 8;
constexpr size_t WS_CBP = WS_ROPE128 + (size_t)M * 64 * 8;
constexpr size_t WS_WFF = al256(WS_CBP + 2 * 16 * 128 * 4);
constexpr size_t WS_WFD = WS_WFF + (size_t)2 * DFF * DM * 2;
constexpr size_t WS_WIN = WS_WFD + (size_t)DM * DFF * 2;
constexpr size_t WS_WG = WS_WIN + (size_t)DIN_S * DM * 2;
constexpr size_t WS_WOA = al256(WS_WG + (size_t)48 * DM * 2);
constexpr size_t WS_WOB = WS_WOA + (size_t)DM * 2048 * 2;
constexpr size_t WS_WO = WS_WOB + (size_t)DM * 2048 * 2;
constexpr size_t WS_WPG = WS_WO + (size_t)DM * DM * 2;
constexpr size_t WS_WPP = WS_WPG + (size_t)DM * DM * 2;
constexpr size_t WS_CK1 = WS_WPP + (size_t)DM * PLE * 2;
constexpr size_t WS_CV1 = WS_CK1 + (size_t)128 * 4096 * 2;
constexpr size_t WS_CK2 = WS_CV1 + (size_t)128 * 4096 * 2;
constexpr size_t WS_CV2 = WS_CK2 + (size_t)128 * 128 * 2;
constexpr size_t WS_P16 = WS_CV2 + (size_t)128 * 128 * 2;
constexpr size_t WS_XN = WS_P16 + (size_t)M * PLE * 2;
constexpr size_t WS_SGA = WS_XN + (size_t)M * DM * 2;
constexpr size_t WS_SGB = WS_SGA + (size_t)M * DM * 2;
constexpr size_t WS_OA = WS_SGB + (size_t)M * DM * 2;
constexpr size_t WS_OB = WS_OA + (size_t)M * 2048 * 2;
constexpr size_t WS_ACT = WS_OB + (size_t)M * 2048 * 2;
constexpr size_t WS_QA = WS_ACT;
constexpr size_t WS_KA = WS_QA + (size_t)M * 2048 * 2;
constexpr size_t WS_VAT = WS_KA + (size_t)M * 256 * 2;
constexpr size_t WS_QB0 = WS_VAT + (size_t)M * 256 * 2;
constexpr size_t WS_QBR = WS_QB0 + (size_t)M * 2048 * 2;
constexpr size_t WS_KC = WS_QBR + (size_t)M * 2048 * 2;
constexpr size_t WS_VC = WS_KC + (size_t)M * 256 * 2;
constexpr size_t WS_KS = WS_VC + (size_t)M * 256 * 2;
constexpr size_t WS_VST = WS_KS + (size_t)M * 256 * 2;
constexpr size_t WS_KW = WS_VST + (size_t)M * 256 * 2;
constexpr size_t WS_VWT = WS_KW + (size_t)M * 256 * 2;
constexpr size_t WS_KCMP = WS_VWT + (size_t)M * 256 * 2;
constexpr size_t WS_VCMPT = WS_KCMP + (size_t)4 * NCP * 128 * 2;
constexpr size_t WS_SGN = WS_VCMPT + (size_t)4 * NCP * 128 * 2;
constexpr size_t WS_QEND = WS_SGN + (size_t)M * 48 * 4;
constexpr size_t WS_PP = WS_SGA;
constexpr size_t WS_END = WS_ACT + (size_t)M * DFF * 2;
static_assert(WS_QEND <= WS_END && WS_PP + (size_t)M * DM * 4 <= WS_OA, "d_ws map");
constexpr int CW_BAR = 4096;
constexpr int CW_Q5 = 16384, CW_Q6 = 16384 + 64 * 8;

typedef __bf16 bf16x2_t __attribute__((ext_vector_type(2)));
__device__ __forceinline__ unsigned cvt_pk_bf16(float lo, float hi) { f32x2 v = {lo, hi}; bf16x2_t b = __builtin_convertvector(v, bf16x2_t); return __builtin_bit_cast(unsigned, b); }
__device__ __forceinline__ float bf_lo(unsigned w) { return __uint_as_float(w << 16); }
__device__ __forceinline__ float bf_hi(unsigned w) { return __uint_as_float(w & 0xffff0000u); }
__device__ __forceinline__ float fast_sigmoid(float x) { return __builtin_amdgcn_rcpf(1.0f + __builtin_amdgcn_exp2f(-x * LOG2E)); }
__device__ __forceinline__ float wave_sum(float v) {
#pragma unroll
    for (int o = 1; o < 64; o <<= 1) v += __shfl_xor(v, o);
    return v;
}
__device__ __forceinline__ float rows4_max(float x) {
    auto a = __builtin_amdgcn_permlane16_swap(__float_as_uint(x), __float_as_uint(x), false, false); x = fmaxf(__uint_as_float(a[0]), __uint_as_float(a[1]));
    auto b = __builtin_amdgcn_permlane32_swap(__float_as_uint(x), __float_as_uint(x), false, false); return fmaxf(__uint_as_float(b[0]), __uint_as_float(b[1]));
}
__device__ __forceinline__ float rows4_sum(float x) {
    auto a = __builtin_amdgcn_permlane16_swap(__float_as_uint(x), __float_as_uint(x), false, false); x = __uint_as_float(a[0]) + __uint_as_float(a[1]);
    auto b = __builtin_amdgcn_permlane32_swap(__float_as_uint(x), __float_as_uint(x), false, false); return __uint_as_float(b[0]) + __uint_as_float(b[1]);
}
__device__ __forceinline__ unsigned half32_umax(unsigned v) {
    unsigned t;
    t = (unsigned)__builtin_amdgcn_update_dpp(0, (int)v, 0xB1, 0xF, 0xF, true); v = v > t ? v : t;
    t = (unsigned)__builtin_amdgcn_update_dpp(0, (int)v, 0x4E, 0xF, 0xF, true); v = v > t ? v : t;
    t = (unsigned)__builtin_amdgcn_update_dpp(0, (int)v, 0x141, 0xF, 0xF, true); v = v > t ? v : t;
    t = (unsigned)__builtin_amdgcn_update_dpp(0, (int)v, 0x140, 0xF, 0xF, true); v = v > t ? v : t;
    auto a = __builtin_amdgcn_permlane16_swap(v, v, false, false); return a[0] > a[1] ? a[0] : a[1];
}
__device__ __forceinline__ float heads8_sum(float v) {
    v += __int_as_float(__builtin_amdgcn_update_dpp(0, __float_as_int(v), 0xB1, 0xF, 0xF, true));
    v += __int_as_float(__builtin_amdgcn_update_dpp(0, __float_as_int(v), 0x4E, 0xF, 0xF, true));
    v += __int_as_float(__builtin_amdgcn_update_dpp(0, __float_as_int(v), 0x141, 0xF, 0xF, true));
    return v;
}
#define LDS_WAIT() asm volatile("s_waitcnt lgkmcnt(0)" ::: "memory")
#define VM_WAIT() asm volatile("s_waitcnt vmcnt(0)" ::: "memory")

namespace pg8 {
constexpr int BM = 256, BK = 64, HALF = 128, HTB = HALF * BK * 2, STAGE_BYTES = 8 * HTB, NXCD = 8, WGM = 8;
__host__ __device__ __forceinline__ int lds_byte(int r, int c) { const int st = (r >> 4) * 2 + (c >> 5), rr = r & 15, cc = c & 31, ob = rr * 64 + cc * 2; return st * 1024 + (ob ^ (((ob >> 9) & 1) << 5)); }
__host__ __device__ __forceinline__ void stage_rc(int b, int& R, int& C) { const int st = b / 1024, sb = b % 1024, swz = sb ^ (((sb >> 9) & 1) << 5); R = (st >> 1) * 16 + swz / 64; C = (st & 1) * 32 + (swz % 64) / 2; }
__host__ __device__ __forceinline__ int perm32(int rho) { const int n = rho >> 4, i = rho & 15; return 8 * (i >> 2) + 4 * n + (i & 3); }

struct Unit { int pm, pn, sub; };
struct Gemm { const bf16* A; const bf16* Bt; const bf16* A2; const bf16* Bt2; int K; int ablk; int bblk; };

struct StaticOrder {
    int nM, nN, nwg, G, c, wgm;
    __device__ void init(int Mr, int N, int G_, int c_, int wgm_ = WGM) { nM = Mr / BM; nN = N / BM; nwg = nM * nN; G = G_; c = c_; wgm = wgm_; }
    __device__ bool next(int i, Unit& u) const {
        const long L = (long)i * G + c; if (L >= nwg) return false;
        int wgid = (int)L; { const int q = nwg / NXCD, r = nwg % NXCD, xcd = wgid % NXCD, off = wgid / NXCD; wgid = (xcd < r ? xcd * (q + 1) : r * (q + 1) + (xcd - r) * q) + off; }
        const int nig = wgm * nN, gid = wgid / nig, fm = gid * wgm, gsz = (nM - fm) < wgm ? (nM - fm) : wgm;
        u.pm = fm + ((wgid % nig) % gsz); u.pn = (wgid % nig) / gsz; u.sub = 0; return true;
    }
};
struct PairOrder : StaticOrder {
    __device__ bool next(int i, Unit& u) const { const bool ok = StaticOrder::next(i >> 1, u); u.sub = i & 1; return ok; }
};

template <class Epi, class Sched>
__device__ __forceinline__ void gemm_phase(LAS unsigned char* lds, const Gemm g, const Sched& S, const Epi& E) {
    const int tid = threadIdx.x, wid = __builtin_amdgcn_readfirstlane(tid >> 6), lane = tid & 63, wr = wid >> 2, wc = wid & 3, fr = lane & 15, fq = lane >> 4;
    const int K = g.K, nt = K / BK;
    unsigned voffA[2], voffB[2];
#pragma unroll
    for (int i = 0; i < 2; ++i) { int R, C; stage_rc(tid * 16 + i * 8192, R, C); const int Rb = Epi::PERM ? ((R & ~31) + perm32(R & 31)) : R;
        voffA[i] = (unsigned)(R * (g.ablk ? BK : K) + C) * 2u; voffB[i] = (unsigned)(Rb * (g.bblk ? BK : K) + C) * 2u; }
    const size_t kstep = (size_t)(BK * 2);
    const size_t hstep = (size_t)HALF * K * 2;
    const size_t tstep = 2 * hstep;
    const size_t kstepA = g.ablk ? (size_t)BM * BK * 2 : kstep, hstepA = g.ablk ? (size_t)HALF * BK * 2 : hstep, tstepA = g.ablk ? (size_t)nt * BM * BK * 2 : tstep;
    const size_t kstepB = g.bblk ? (size_t)BM * BK * 2 : kstep, hstepB = g.bblk ? (size_t)HALF * BK * 2 : hstep, tstepB = g.bblk ? (size_t)nt * BM * BK * 2 : tstep;
    const unsigned ldsw = (unsigned)wid * 1024u;
    const int aoff = lds_byte(wr * 64 + fr, fq * 8), boff = lds_byte(wc * 32 + fr, fq * 8);
#define PG8_SA(b, h) (((b) * 2 + (h)) * HTB)
#define PG8_SB(b, h) ((4 + (b) * 2 + (h)) * HTB)
#define PG8_STAGE(bufoff, gbase, voff) do { _Pragma("unroll") for (int _i = 0; _i < 2; ++_i) \
        __builtin_amdgcn_global_load_lds((const unsigned*)((const char*)(gbase) + (voff)[_i]), (LAS unsigned*)(lds + (bufoff) + ldsw + _i * 8192), 16, 0, 0); } while (0)
#define PG8_LDA(dst, b, h) do { _Pragma("unroll") for (int m = 0; m < 4; ++m) _Pragma("unroll") for (int k = 0; k < 2; ++k) dst[m][k] = *(const LAS bf16x8*)(lds + PG8_SA(b, h) + aoff + m * 2048 + k * 1024); } while (0)
#define PG8_LDB(dst, b, h) do { _Pragma("unroll") for (int n = 0; n < 2; ++n) _Pragma("unroll") for (int k = 0; k < 2; ++k) dst[n][k] = *(const LAS bf16x8*)(lds + PG8_SB(b, h) + boff + n * 2048 + k * 1024); } while (0)
#define PG8_MMA(ai, bj, At, Bt) do { __builtin_amdgcn_s_setprio(1); _Pragma("unroll") for (int m = 0; m < 4; ++m) _Pragma("unroll") for (int n = 0; n < 2; ++n) _Pragma("unroll") for (int k = 0; k < 2; ++k) \
        acc[ai][bj][m][n] = __builtin_amdgcn_mfma_f32_16x16x32_bf16(Bt[n][k], At[m][k], acc[ai][bj][m][n], 0, 0, 0); __builtin_amdgcn_s_setprio(0); } while (0)
#define PG8_WAIT_V(n) asm volatile("s_waitcnt vmcnt(" #n ")" ::: "memory")
#define PG8_WAIT_L(n) asm volatile("s_waitcnt lgkmcnt(" #n ")" ::: "memory")
#define PG8_BAR __builtin_amdgcn_s_barrier()
#define PG8_SCHED __builtin_amdgcn_sched_barrier(0)
    Unit cur, nxt; int ui = 0;
    if (!S.next(0, cur)) return;
    f32x4 acc[2][2][4][2];
#pragma unroll
    for (int a = 0; a < 2; ++a)
#pragma unroll
        for (int b = 0; b < 2; ++b)
#pragma unroll
            for (int m = 0; m < 4; ++m)
#pragma unroll
                for (int n = 0; n < 2; ++n) acc[a][b][m][n] = (f32x4){0.f, 0.f, 0.f, 0.f};
    bf16x8 At[4][2], B0[2][2], B1[2][2];
    const char* cA = (const char*)(cur.sub ? g.A2 : g.A) + (size_t)cur.pm * tstepA; const char* cB = (const char*)(cur.sub ? g.Bt2 : g.Bt) + (size_t)cur.pn * tstepB;
    PG8_STAGE(PG8_SB(0, 0), cB, voffB); PG8_STAGE(PG8_SB(0, 1), cB + hstepB, voffB); PG8_STAGE(PG8_SA(0, 0), cA, voffA); PG8_STAGE(PG8_SA(0, 1), cA + hstepA, voffA);
    if (wr == 1) PG8_BAR;
    PG8_WAIT_V(2); PG8_BAR;
    PG8_STAGE(PG8_SB(1, 0), cB + kstepB, voffB); PG8_STAGE(PG8_SA(1, 0), cA + kstepA, voffA); PG8_STAGE(PG8_SB(1, 1), cB + hstepB + kstepB, voffB);
    PG8_WAIT_V(6); PG8_BAR;
    for (;;) {
        const bool has_next = S.next(ui + 1, nxt);
        const char* nA = has_next ? (const char*)(nxt.sub ? g.A2 : g.A) + (size_t)nxt.pm * tstepA : cA; const char* nB = has_next ? (const char*)(nxt.sub ? g.Bt2 : g.Bt) + (size_t)nxt.pn * tstepB : cB;
        for (int t = 0; t < nt; t += 2) {
            const bool last = (t == nt - 2);
            const char* a1 = cA + (size_t)(t + 1) * kstepA;
            const char* a2 = last ? nA : cA + (size_t)(t + 2) * kstepA; const char* b2 = last ? nB : cB + (size_t)(t + 2) * kstepB;
            const char* a3 = a2 + kstepA; const char* b3 = b2 + kstepB;
            PG8_LDB(B0, 0, 0); PG8_LDB(B1, 0, 1); PG8_SCHED; PG8_LDA(At, 0, 0); PG8_STAGE(PG8_SA(1, 1), a1 + hstepA, voffA);
            PG8_WAIT_V(8); PG8_WAIT_L(0); PG8_BAR; PG8_MMA(0, 0, At, B0); PG8_MMA(0, 1, At, B1); PG8_BAR; PG8_SCHED;
            PG8_LDA(At, 0, 1); PG8_STAGE(PG8_SB(0, 0), b2, voffB); PG8_STAGE(PG8_SB(0, 1), b2 + hstepB, voffB); PG8_STAGE(PG8_SA(0, 0), a2, voffA);
            PG8_WAIT_V(8); PG8_WAIT_L(0); PG8_BAR; PG8_MMA(1, 0, At, B0); PG8_MMA(1, 1, At, B1); PG8_BAR; PG8_SCHED;
            PG8_LDB(B0, 1, 0); PG8_LDB(B1, 1, 1); PG8_SCHED; PG8_LDA(At, 1, 0); PG8_STAGE(PG8_SA(0, 1), a2 + hstepA, voffA);
            PG8_WAIT_V(8); PG8_WAIT_L(0); PG8_BAR; PG8_MMA(0, 0, At, B0); PG8_MMA(0, 1, At, B1); PG8_BAR; PG8_SCHED;
            PG8_LDA(At, 1, 1); PG8_STAGE(PG8_SB(1, 0), b3, voffB); PG8_STAGE(PG8_SB(1, 1), b3 + hstepB, voffB); PG8_STAGE(PG8_SA(1, 0), a3, voffA);
            PG8_WAIT_V(8); PG8_WAIT_L(0); PG8_BAR; PG8_MMA(1, 0, At, B0); PG8_MMA(1, 1, At, B1); PG8_BAR; PG8_SCHED;
        }
        if (wr == 0) PG8_BAR;
        E(acc, cur, wr, wc, fr, fq);
        if (!has_next) break;
#pragma unroll
        for (int a = 0; a < 2; ++a)
#pragma unroll
            for (int b = 0; b < 2; ++b)
#pragma unroll
                for (int m = 0; m < 4; ++m)
#pragma unroll
                    for (int n = 0; n < 2; ++n) acc[a][b][m][n] = (f32x4){0.f, 0.f, 0.f, 0.f};
        cur = nxt; cA = nA; cB = nB; ++ui;
        if (wr == 1) PG8_BAR;
    }
    PG8_WAIT_V(0);
    PG8_BAR;
#undef PG8_SA
#undef PG8_SB
#undef PG8_STAGE
#undef PG8_LDA
#undef PG8_LDB
#undef PG8_MMA
#undef PG8_WAIT_V
#undef PG8_WAIT_L
#undef PG8_BAR
#undef PG8_SCHED
}

struct EpiFF {
    static constexpr bool PERM = true;
    bf16* ACT;
    __device__ __forceinline__ void operator()(const f32x4 (&acc)[2][2][4][2], const Unit& u, int wr, int wc, int fr, int fq) const {
        const int row0 = u.pm * BM + wr * 64 + fr, col0 = u.pn * 128 + wc * 32 + 8 * fq;
#pragma unroll
        for (int ai = 0; ai < 2; ++ai)
#pragma unroll
            for (int m = 0; m < 4; ++m) {
                const f32x4 g0 = acc[ai][0][m][0], g1 = acc[ai][0][m][1], u0 = acc[ai][1][m][0], u1 = acc[ai][1][m][1];
                float a[8];
#pragma unroll
                for (int j = 0; j < 4; ++j) { a[j] = g0[j] * fast_sigmoid(g0[j]) * u0[j]; a[4 + j] = g1[j] * fast_sigmoid(g1[j]) * u1[j]; }
                u32x4 w; w.x = cvt_pk_bf16(a[0], a[1]); w.y = cvt_pk_bf16(a[2], a[3]); w.z = cvt_pk_bf16(a[4], a[5]); w.w = cvt_pk_bf16(a[6], a[7]);
                *(u32x4*)(ACT + (((size_t)u.pm * (DFF / 64) + (col0 >> 6)) * BM + (wr * 64 + fr + ai * HALF + m * 16)) * 64 + (col0 & 63)) = w;
            }
    }
};
struct EpiRes {
    static constexpr bool PERM = false;
    const float* resid; float* out; float scale;
    __device__ __forceinline__ void operator()(const f32x4 (&acc)[2][2][4][2], const Unit& u, int wr, int wc, int fr, int fq) const {
        int row0 = u.pm * BM + wr * 64 + fr; const int col0 = u.pn * BM + wc * 32 + 4 * fq;
        asm volatile("" : "+v"(row0));
#pragma unroll
        for (int ai = 0; ai < 2; ++ai)
#pragma unroll
            for (int mh = 0; mh < 2; ++mh) {
                f32x4 r[2][2][2];
#pragma unroll
                for (int m2 = 0; m2 < 2; ++m2) { const size_t off = (size_t)(row0 + ai * HALF + (2 * mh + m2) * 16) * DM + col0;
#pragma unroll
                    for (int bj = 0; bj < 2; ++bj)
#pragma unroll
                        for (int n = 0; n < 2; ++n) r[m2][bj][n] = *(const f32x4*)(resid + off + bj * HALF + n * 16); }
                asm volatile("" ::: "memory");
#pragma unroll
                for (int m2 = 0; m2 < 2; ++m2) { const size_t off = (size_t)(row0 + ai * HALF + (2 * mh + m2) * 16) * DM + col0;
#pragma unroll
                    for (int bj = 0; bj < 2; ++bj)
#pragma unroll
                        for (int n = 0; n < 2; ++n) *(f32x4*)(out + off + bj * HALF + n * 16) = r[m2][bj][n] + acc[ai][bj][2 * mh + m2][n] * scale; }
                asm volatile("" ::: "memory");
            }
    }
};
struct EpiF32 {
    static constexpr bool PERM = false;
    float* C;
    __device__ __forceinline__ void operator()(const f32x4 (&acc)[2][2][4][2], const Unit& u, int wr, int wc, int fr, int fq) const {
        const int row0 = u.pm * BM + wr * 64 + fr, col0 = u.pn * BM + wc * 32 + 4 * fq;
#pragma unroll
        for (int ai = 0; ai < 2; ++ai)
#pragma unroll
            for (int m = 0; m < 4; ++m) { float* rowp = C + (size_t)(row0 + ai * HALF + m * 16) * DM + col0;
#pragma unroll
                for (int bj = 0; bj < 2; ++bj)
#pragma unroll
                    for (int n = 0; n < 2; ++n) *(f32x4*)(rowp + bj * HALF + n * 16) = acc[ai][bj][m][n]; }
    }
};
struct EpiPle {
    static constexpr bool PERM = false;
    const float* PP; float* out;
    __device__ __forceinline__ void operator()(const f32x4 (&acc)[2][2][4][2], const Unit& u, int wr, int wc, int fr, int fq) const {
        int row0 = u.pm * BM + wr * 64 + fr; const int col0 = u.pn * BM + wc * 32 + 4 * fq;
        asm volatile("" : "+v"(row0));
#pragma unroll
        for (int ai = 0; ai < 2; ++ai)
#pragma unroll
            for (int mh = 0; mh < 2; ++mh) {
                f32x4 r[2][2][2], pp[2][2][2];
#pragma unroll
                for (int m2 = 0; m2 < 2; ++m2) { const size_t off = (size_t)(row0 + ai * HALF + (2 * mh + m2) * 16) * DM + col0;
#pragma unroll
                    for (int bj = 0; bj < 2; ++bj)
#pragma unroll
                        for (int n = 0; n < 2; ++n) { r[m2][bj][n] = *(const f32x4*)(out + off + bj * HALF + n * 16); pp[m2][bj][n] = *(const f32x4*)(PP + off + bj * HALF + n * 16); } }
                asm volatile("" ::: "memory");
#pragma unroll
                for (int m2 = 0; m2 < 2; ++m2) { const size_t off = (size_t)(row0 + ai * HALF + (2 * mh + m2) * 16) * DM + col0;
#pragma unroll
                    for (int bj = 0; bj < 2; ++bj)
#pragma unroll
                        for (int n = 0; n < 2; ++n) { const f32x4 a = acc[ai][bj][2 * mh + m2][n]; f32x4 sv_;
#pragma unroll
                            for (int j = 0; j < 4; ++j) sv_[j] = r[m2][bj][n][j] + pp[m2][bj][n][j] * fast_sigmoid(a[j]);
                            *(f32x4*)(out + off + bj * HALF + n * 16) = sv_; } }
                asm volatile("" ::: "memory");
            }
    }
};
struct EpiMerge {
    static constexpr bool PERM = true;
    const bf16* SGA; const bf16* SGB; bf16* MG;
    __device__ __forceinline__ void operator()(const f32x4 (&acc)[2][2][4][2], const Unit& u, int wr, int wc, int fr, int fq) const {
        int row0 = u.pm * BM + wr * 64 + fr; const int col0 = u.pn * BM + wc * 32 + 8 * fq;
        asm volatile("" : "+v"(row0));
        const bf16* SG = u.sub ? SGB : SGA;
#pragma unroll
        for (int ai = 0; ai < 2; ++ai) {
            u32x4 sg[4][2], pm_[4][2];
#pragma unroll
            for (int m = 0; m < 4; ++m)
#pragma unroll
                for (int bj = 0; bj < 2; ++bj) { const size_t o = (size_t)(row0 + ai * HALF + m * 16) * DM + col0 + bj * HALF; sg[m][bj] = *(const u32x4*)(SG + o); pm_[m][bj] = u.sub ? *(const u32x4*)(MG + o) : (u32x4){0u, 0u, 0u, 0u}; }
            asm volatile("" ::: "memory");
#pragma unroll
            for (int m = 0; m < 4; ++m)
#pragma unroll
                for (int bj = 0; bj < 2; ++bj) {
                    const size_t o = (size_t)(row0 + ai * HALF + m * 16) * DM + col0 + bj * HALF;
                    const u32x4 g_ = sg[m][bj], p = pm_[m][bj]; const f32x4 v0 = acc[ai][bj][m][0], v1 = acc[ai][bj][m][1];
                    const float r[8] = { v0[0] * bf_lo(g_.x) + bf_lo(p.x), v0[1] * bf_hi(g_.x) + bf_hi(p.x), v0[2] * bf_lo(g_.y) + bf_lo(p.y), v0[3] * bf_hi(g_.y) + bf_hi(p.y),
                                         v1[0] * bf_lo(g_.z) + bf_lo(p.z), v1[1] * bf_hi(g_.z) + bf_hi(p.z), v1[2] * bf_lo(g_.w) + bf_lo(p.w), v1[3] * bf_hi(g_.w) + bf_hi(p.w) };
                    u32x4 w; w.x = cvt_pk_bf16(r[0], r[1]); w.y = cvt_pk_bf16(r[2], r[3]); w.z = cvt_pk_bf16(r[4], r[5]); w.w = cvt_pk_bf16(r[6], r[7]);
                    *(u32x4*)(MG + o) = w;
                }
            asm volatile("" ::: "memory");
        }
    }
};
struct EpiIn {
    static constexpr bool PERM = true;
    unsigned char* ws;
    __device__ __forceinline__ static u32x4 pack8(const f32x4 a, const f32x4 b) { u32x4 w; w.x = cvt_pk_bf16(a[0], a[1]); w.y = cvt_pk_bf16(a[2], a[3]); w.z = cvt_pk_bf16(b[0], b[1]); w.w = cvt_pk_bf16(b[2], b[3]); return w; }
    __device__ __forceinline__ void operator()(const f32x4 (&acc)[2][2][4][2], const Unit& u, int wr, int wc, int fr, int fq) const {
        const int pn = u.pn, row0 = u.pm * BM + wr * 64 + fr;
        if (pn >= 24) {
            bf16* dst = (bf16*)(ws + (pn >= 40 ? WS_SGB : WS_SGA)); const int col0 = ((pn - 24) & 15) * 256 + wc * 32 + 8 * fq;
#pragma unroll
            for (int ai = 0; ai < 2; ++ai)
#pragma unroll
                for (int m = 0; m < 4; ++m)
#pragma unroll
                    for (int bj = 0; bj < 2; ++bj) { f32x4 a = acc[ai][bj][m][0], b = acc[ai][bj][m][1];
#pragma unroll
                        for (int j = 0; j < 4; ++j) { a[j] = fast_sigmoid(a[j]); b[j] = fast_sigmoid(b[j]); }
                        *(u32x4*)(dst + (size_t)(row0 + ai * HALF + m * 16) * DM + col0 + bj * HALF) = pack8(a, b); }
        } else if ((MK_SKIP & 1) && pn < 9) {
        } else if ((MK_SKIP & 2) && ((pn >= 10 && pn < 18) || pn == 20 || pn == 22)) {
        } else if ((MK_SKIP & 4) && (pn == 18 || pn == 19)) {
        } else if ((MK_SKIP & 8) && (pn == 9 || pn == 21 || pn == 23)) {
        } else if (pn < 9) {
            bf16* dst = (bf16*)(ws + (pn == 8 ? WS_KA : WS_QA)); const int ld = pn == 8 ? 256 : 2048; const int q = 4 * (wc & 1) + fq;
            const f32x4* rt = (const f32x4*)(ws + WS_ROPE64);
#pragma unroll
            for (int ai = 0; ai < 2; ++ai)
#pragma unroll
                for (int m = 0; m < 4; ++m) { const int row = row0 + ai * HALF + m * 16; const f32x4* rr = rt + (size_t)row * 16 + 2 * q; const f32x4 cs0 = rr[0], cs1 = rr[1];
#pragma unroll
                    for (int bj = 0; bj < 2; ++bj) { const f32x4 x1 = acc[ai][bj][m][0], x2 = acc[ai][bj][m][1]; f32x4 o1, o2;
                        o1[0] = x1[0] * cs0[0] - x2[0] * cs0[1]; o2[0] = x2[0] * cs0[0] + x1[0] * cs0[1];
                        o1[1] = x1[1] * cs0[2] - x2[1] * cs0[3]; o2[1] = x2[1] * cs0[2] + x1[1] * cs0[3];
                        o1[2] = x1[2] * cs1[0] - x2[2] * cs1[1]; o2[2] = x2[2] * cs1[0] + x1[2] * cs1[1];
                        o1[3] = x1[3] * cs1[2] - x2[3] * cs1[3]; o2[3] = x2[3] * cs1[2] + x1[3] * cs1[3];
                        const int hl = 2 * bj + (wc >> 1); const int head = (pn == 8 ? 0 : 4 * pn) + hl;
                        *(u32x4*)(dst + (size_t)row * ld + head * 64 + 8 * q) = pack8(o1, o2); } }
        } else if ((pn >= 10 && pn < 18) || pn == 20 || pn == 22) {
            const int q = 4 * wc + fq; const f32x4* rt = (const f32x4*)(ws + WS_ROPE128);
            bf16* dst = (bf16*)(ws + (pn == 20 ? WS_KS : pn == 22 ? WS_KW : WS_QBR)); const int ld = pn >= 20 ? 256 : 2048; bf16* q0 = (bf16*)(ws + WS_QB0);
#pragma unroll
            for (int ai = 0; ai < 2; ++ai)
#pragma unroll
                for (int m = 0; m < 4; ++m) { const int row = row0 + ai * HALF + m * 16; const f32x4* rr = rt + (size_t)row * 32 + 2 * q; const f32x4 cs0 = rr[0], cs1 = rr[1];
#pragma unroll
                    for (int bj = 0; bj < 2; ++bj) { const f32x4 x1 = acc[ai][bj][m][0], x2 = acc[ai][bj][m][1]; f32x4 o1, o2;
                        o1[0] = x1[0] * cs0[0] - x2[0] * cs0[1]; o2[0] = x2[0] * cs0[0] + x1[0] * cs0[1];
                        o1[1] = x1[1] * cs0[2] - x2[1] * cs0[3]; o2[1] = x2[1] * cs0[2] + x1[1] * cs0[3];
                        o1[2] = x1[2] * cs1[0] - x2[2] * cs1[1]; o2[2] = x2[2] * cs1[0] + x1[2] * cs1[1];
                        o1[3] = x1[3] * cs1[2] - x2[3] * cs1[3]; o2[3] = x2[3] * cs1[2] + x1[3] * cs1[3];
                        const int head = (pn >= 20 ? 0 : 2 * (pn - 10)) + bj;
                        *(u32x4*)(dst + (size_t)row * ld + head * 128 + 8 * q) = pack8(o1, o2);
                        if (pn < 18) { u32x2 a, b; a.x = cvt_pk_bf16(x1[0], x1[1]); a.y = cvt_pk_bf16(x1[2], x1[3]); b.x = cvt_pk_bf16(x2[0], x2[1]); b.y = cvt_pk_bf16(x2[2], x2[3]);
                            *(u32x2*)(q0 + (size_t)row * 2048 + head * 128 + 4 * q) = a; *(u32x2*)(q0 + (size_t)row * 2048 + head * 128 + 64 + 4 * q) = b; } } }
        } else if (pn == 18 || pn == 19) {
            bf16* dst = (bf16*)(ws + (pn == 18 ? WS_KC : WS_VC)); const int col0 = wc * 32 + 8 * fq;
#pragma unroll
            for (int ai = 0; ai < 2; ++ai)
#pragma unroll
                for (int m = 0; m < 4; ++m)
#pragma unroll
                    for (int bj = 0; bj < 2; ++bj) *(u32x4*)(dst + (size_t)(row0 + ai * HALF + m * 16) * 256 + col0 + bj * HALF) = pack8(acc[ai][bj][m][0], acc[ai][bj][m][1]);
        } else {
            bf16* dst = (bf16*)(ws + (pn == 9 ? WS_VAT : pn == 21 ? WS_VST : WS_VWT));
#pragma unroll
            for (int ai = 0; ai < 2; ++ai)
#pragma unroll
                for (int m = 0; m < 4; ++m) { const int row = row0 + ai * HALF + m * 16; const int b = row / T, t = row % T;
#pragma unroll
                    for (int bj = 0; bj < 2; ++bj) {
                        const int c0 = bj * HALF + wc * 32 + 8 * fq;
                        bf16* p = dst + ((size_t)b * 256 + c0) * T + t;
                        const f32x4 a = acc[ai][bj][m][0], c = acc[ai][bj][m][1];
#pragma unroll
                        for (int j = 0; j < 4; ++j) { p[(size_t)j * T] = (bf16)(cvt_pk_bf16(a[j], 0.f) & 0xffffu); p[(size_t)(4 + j) * T] = (bf16)(cvt_pk_bf16(c[j], 0.f) & 0xffffu); } } }
        }
    }
};
}

#define XB_TMO      128
#define XB_XCNT(j)  (256  + 64 * (j))
#define XB_XSUB(j)  (1280 + 64 * (j))
#define XB_XGEN(j)  (2304 + 64 * (j))
#define XB_TOP      3328
#define XB_TOPGEN   3392
#define XCD_BAR_WORDS 3456
#define XB_SPIN_CAP (1u << 18)
__device__ __forceinline__ unsigned xb_ld(unsigned* p)              { return __hip_atomic_load(p, __ATOMIC_RELAXED, __HIP_MEMORY_SCOPE_AGENT); }
__device__ __forceinline__ unsigned xb_add(unsigned* p, unsigned v) { return __hip_atomic_fetch_add(p, v, __ATOMIC_RELAXED, __HIP_MEMORY_SCOPE_AGENT); }
__device__ __forceinline__ unsigned xb_xcc_id() { return (unsigned)__builtin_amdgcn_s_getreg((3 << 11) | 20) & 0xFu; }
#define XB_SPIN(cond, bar) do { unsigned _sp = 0; while (cond) { __builtin_amdgcn_s_sleep(1); \
    if ((++_sp & 255u) == 0u) { if (xb_ld(&(bar)[XB_TMO])) break; if (_sp > XB_SPIN_CAP) { atomicAdd(&(bar)[XB_TMO], 1u); break; } } } } while (0)
struct XcdBarrier { unsigned* bar; unsigned x; volatile LAS unsigned* st; };
__device__ __forceinline__ XcdBarrier xcd_barrier_post(unsigned* bar, volatile LAS unsigned* st) {
    XcdBarrier b; b.bar = bar; b.x = xb_xcc_id(); b.st = st;
    if (threadIdx.x == 0) (void)xb_add(&bar[XB_XCNT(b.x)], 1u);
    return b;
}
__device__ __forceinline__ void xcd_barrier_complete(unsigned* bar, unsigned x, unsigned& nloc, unsigned& nx) {
    const unsigned G = gridDim.x * gridDim.y * gridDim.z;
    unsigned sum, cnt, mine, sp = 0u;
    for (;;) {
        sum = 0u; cnt = 0u; mine = 0u;
#pragma unroll
        for (unsigned j = 0; j < 16; ++j) { const unsigned c = xb_ld(&bar[XB_XCNT(j)]); sum += c; cnt += (c > 0u) ? 1u : 0u; mine = (j == x) ? c : mine; }
        if (sum == G) break;
        __builtin_amdgcn_s_sleep(1);
        if ((++sp & 255u) == 0u) { if (xb_ld(&bar[XB_TMO])) break; if (sp > XB_SPIN_CAP) { atomicAdd(&bar[XB_TMO], 1u); break; } }
    }
    nloc = mine > 0u ? mine : 1u; nx = cnt > 0u ? cnt : 1u;
}
__device__ __forceinline__ void xcd_barrier(const XcdBarrier& b) {
    asm volatile("s_waitcnt vmcnt(0)" ::: "memory");
    __syncthreads();
    if (threadIdx.x == 0) {
        unsigned* bar = b.bar;
        __builtin_amdgcn_s_waitcnt(0);
        unsigned nloc = b.st[0], nx = b.st[1];
        if (nloc == 0u) { xcd_barrier_complete(bar, b.x, nloc, nx); b.st[0] = nloc; b.st[1] = nx; }
        const unsigned old = xb_add(&bar[XB_XSUB(b.x)], 1u);
        const unsigned gen = old / nloc;
        if (old + 1u == (gen + 1u) * nloc) {
            __builtin_amdgcn_fence(__ATOMIC_RELEASE, "agent");
            asm volatile("s_waitcnt vmcnt(0)" ::: "memory");
            const unsigned og = xb_add(&bar[XB_TOP], 1u);
            const unsigned tg = og / nx;
            if (og + 1u == (tg + 1u) * nx) xb_add(&bar[XB_TOPGEN], 1u);
            else XB_SPIN(xb_ld(&bar[XB_TOPGEN]) == tg, bar);
            __builtin_amdgcn_fence(__ATOMIC_ACQUIRE, "agent");
            xb_add(&bar[XB_XGEN(b.x)], 1u);
            asm volatile("s_waitcnt vmcnt(0)" ::: "memory");
        } else {
            XB_SPIN(xb_ld(&bar[XB_XGEN(b.x)]) == gen, bar);
            __builtin_amdgcn_fence(__ATOMIC_ACQUIRE, "agent");
            asm volatile("s_waitcnt vmcnt(0)" ::: "memory");
        }
    }
    __syncthreads();
}

enum { MAP_ID = 0, MAP_GATE = 1, MAP_UP = 2, MAP_WIN = 3, MAP_BLK = 4 };
__device__ __forceinline__ long win_row_off(int j) {
    if (j >= 6144) {
        if (j < 6192) return (long)((WS_WG - WS_WIN) / 2) + (long)(j - 6144) * DM;
        return (long)(j - 48) * DM;
    }
    int s = j;
    if (j < 2304) { const int d = j & 63, h = j & ~63; s = h + (d < 32 ? 8 * (d >> 2) + (d & 3) : 8 * ((d - 32) >> 2) + 4 + (d & 3)); }
    else if ((j >= 2560 && j < 4608) || (j >= 5120 && j < 5376) || (j >= 5632 && j < 5888)) { const int d = j & 127, h = j & ~127; s = h + (d < 64 ? 8 * (d >> 2) + (d & 3) : 8 * ((d - 64) >> 2) + 4 + (d & 3)); }
    return (long)s * DM;
}
__device__ __forceinline__ long map_row_off(int map, int ns, int K) {
    if (map == MAP_ID) return (long)ns * K;
    if (map == MAP_GATE) return (long)((ns >> 7) * 256 + (ns & 127)) * K;
    if (map == MAP_UP) return (long)((ns >> 7) * 256 + 128 + (ns & 127)) * K;
    return win_row_off(ns);
}
__device__ __forceinline__ void tr_item(const float* W, int K, int N, bf16* dst, int map, int item, int lane) {
    const int nblk = (N + 31) / 32, kb = item / nblk, nb = item % nblk, k0 = 64 * kb + 8 * (lane >> 3), n0 = 32 * nb + 4 * (lane & 7);
    if (n0 >= N) return;
    f32x4 v[8];
#pragma unroll
    for (int r = 0; r < 8; ++r) v[r] = *(const f32x4*)(W + (size_t)(k0 + r) * N + n0);
#pragma unroll
    for (int c = 0; c < 4; ++c) {
        u32x4 o; o.x = cvt_pk_bf16(v[0][c], v[1][c]); o.y = cvt_pk_bf16(v[2][c], v[3][c]); o.z = cvt_pk_bf16(v[4][c], v[5][c]); o.w = cvt_pk_bf16(v[6][c], v[7][c]);
        if (map == MAP_BLK) { const int n = n0 + c; *(u32x4*)(dst + (((size_t)(n >> 8) * (K >> 6) + (k0 >> 6)) * 256 + (n & 255)) * 64 + (k0 & 63)) = o; }
        else *(u32x4*)(dst + map_row_off(map, n0 + c, K) + k0) = o;
    }
}
__device__ __forceinline__ void tr_item2(const float* W, int K, int N, bf16* dst, int map, int itemA, int itemB, int lane) {
    const int nblk = N / 32;
    const int kA = 64 * (itemA / nblk) + 8 * (lane >> 3), nA = 32 * (itemA % nblk) + 4 * (lane & 7);
    const int kB = 64 * (itemB / nblk) + 8 * (lane >> 3), nB = 32 * (itemB % nblk) + 4 * (lane & 7);
    f32x4 va[8], vb[8];
#pragma unroll
    for (int r = 0; r < 8; ++r) va[r] = *(const f32x4*)(W + (size_t)(kA + r) * N + nA);
#pragma unroll
    for (int r = 0; r < 8; ++r) vb[r] = *(const f32x4*)(W + (size_t)(kB + r) * N + nB);
#pragma unroll
    for (int c = 0; c < 4; ++c) {
        u32x4 o; o.x = cvt_pk_bf16(va[0][c], va[1][c]); o.y = cvt_pk_bf16(va[2][c], va[3][c]); o.z = cvt_pk_bf16(va[4][c], va[5][c]); o.w = cvt_pk_bf16(va[6][c], va[7][c]);
        if (map == MAP_BLK) { const int n = nA + c; *(u32x4*)(dst + (((size_t)(n >> 8) * (K >> 6) + (kA >> 6)) * 256 + (n & 255)) * 64 + (kA & 63)) = o; }
        else *(u32x4*)(dst + map_row_off(map, nA + c, K) + kA) = o;
    }
#pragma unroll
    for (int c = 0; c < 4; ++c) {
        u32x4 o; o.x = cvt_pk_bf16(vb[0][c], vb[1][c]); o.y = cvt_pk_bf16(vb[2][c], vb[3][c]); o.z = cvt_pk_bf16(vb[4][c], vb[5][c]); o.w = cvt_pk_bf16(vb[6][c], vb[7][c]);
        if (map == MAP_BLK) { const int n = nB + c; *(u32x4*)(dst + (((size_t)(n >> 8) * (K >> 6) + (kB >> 6)) * 256 + (n & 255)) * 64 + (kB & 63)) = o; }
        else *(u32x4*)(dst + map_row_off(map, nB + c, K) + kB) = o;
    }
}
struct MatDesc { const float* W; bf16* dst; int K, N, map, items; };
__device__ __forceinline__ int items_of(int K, int N) { return (K / 64) * ((N + 31) / 32); }

__device__ __forceinline__ void norm_row_bf16(const float* xrow, const float* g, bf16* orow, int lane) {
    asm volatile("" : "+v"(lane));
    const f32x4* xr = (const f32x4*)xrow + lane; const f32x4* gr = (const f32x4*)g + lane;
    f32x4 v[16]; float s = 0.f;
#pragma unroll
    for (int j = 0; j < 16; ++j) { v[j] = xr[64 * j]; s += (v[j].x * v[j].x + v[j].y * v[j].y) + (v[j].z * v[j].z + v[j].w * v[j].w); }
    const float r = 1.0f / sqrtf(wave_sum(s) * (1.0f / DM) + EPS);
    u32x2* o8 = (u32x2*)orow + lane;
#pragma unroll
    for (int j = 0; j < 16; ++j) { const f32x4 gg = gr[64 * j]; u32x2 w; w.x = cvt_pk_bf16(v[j].x * r * gg.x, v[j].y * r * gg.y); w.y = cvt_pk_bf16(v[j].z * r * gg.z, v[j].w * r * gg.w); o8[64 * j] = w; }
}
__device__ __forceinline__ void norm_row_f32_inplace(float* xrow, const float* g, int lane) {
    asm volatile("" : "+v"(lane));
    f32x4* xr = (f32x4*)xrow + lane; const f32x4* gr = (const f32x4*)g + lane;
    f32x4 v[16]; float s = 0.f;
#pragma unroll
    for (int j = 0; j < 16; ++j) { v[j] = xr[64 * j]; s += (v[j].x * v[j].x + v[j].y * v[j].y) + (v[j].z * v[j].z + v[j].w * v[j].w); }
    const float r = 1.0f / sqrtf(wave_sum(s) * (1.0f / DM) + EPS);
#pragma unroll
    for (int j = 0; j < 16; ++j) { const f32x4 gg = gr[64 * j]; xr[64 * j] = (f32x4){v[j].x * r * gg.x, v[j].y * r * gg.y, v[j].z * r * gg.z, v[j].w * r * gg.w}; }
}
__device__ __forceinline__ void sincos_d(double a, float& c, float& s) {
    const double k = __builtin_rint(a * 0.6366197723675814);
    double r = (a - k * 1.5707963109016418) - k * 1.5893254773528196e-08;
    const double r2 = r * r;
    double sn = r2 * (1.0 / 6227020800.0) - (1.0 / 39916800.0); sn = sn * r2 + (1.0 / 362880.0); sn = sn * r2 - (1.0 / 5040.0); sn = sn * r2 + (1.0 / 120.0); sn = sn * r2 - (1.0 / 6.0); sn = sn * r2 * r + r;
    double cn = r2 * (-1.0 / 87178291200.0) + (1.0 / 479001600.0); cn = cn * r2 - (1.0 / 3628800.0); cn = cn * r2 + (1.0 / 40320.0); cn = cn * r2 - (1.0 / 720.0); cn = cn * r2 + (1.0 / 24.0); cn = cn * r2 - 0.5; cn = cn * r2 + 1.0;
    const int q = ((int)k) & 3;
    const double cc = (q == 0) ? cn : (q == 1) ? -sn : (q == 2) ? -cn : sn;
    const double ss = (q == 0) ? sn : (q == 1) ? cn : (q == 2) ? -sn : -cn;
    c = (float)cc; s = (float)ss;
}

#define MFMA16(a, b, c) __builtin_amdgcn_mfma_f32_16x16x32_bf16((a), (b), (c), 0, 0, 0)
template <int D> struct KVRegs { bf16x8 ka[D / 32], kb[D / 32], v[D / 16]; };
template <int D> struct AttnW { bf16x8 q[D / 32]; f32x4 O[D / 16]; float m, l; };

template <int D> __device__ __forceinline__ void attn_load_q(AttnW<D>& w, const bf16* qrow  , int quad) {
#pragma unroll
    for (int kk = 0; kk < D / 32; ++kk) w.q[kk] = *(const bf16x8*)(qrow + kk * 32 + quad * 8);
}
typedef __amdgpu_buffer_rsrc_t rsrc_t;
__device__ __forceinline__ rsrc_t make_rsrc(const void* p) { return __builtin_amdgcn_make_buffer_rsrc((void*)p, 0, 0x7fffffff, 0x00020000); }
__device__ __forceinline__ bf16x8 buf_ld16(rsrc_t r, unsigned voff, unsigned soff) { const u32x4 v = __builtin_amdgcn_raw_buffer_load_b128(r, voff, soff, 0); return __builtin_bit_cast(bf16x8, v); }
template <int D> __device__ __forceinline__ void attn_load_k(KVRegs<D>& r, rsrc_t Kb, int ldk, int key0, int lane) {
    const int rho = lane & 15, quad = lane >> 4;
    const unsigned lo = (unsigned)(((8 * (rho >> 2) + (rho & 3)) * ldk + quad * 8) * 2);
    const unsigned so = (unsigned)(key0 * ldk * 2);
#pragma unroll
    for (int kk = 0; kk < D / 32; ++kk) { r.ka[kk] = buf_ld16(Kb, lo, so + kk * 64); r.kb[kk] = buf_ld16(Kb, lo, so + 8 * ldk + kk * 64); }
}
template <int D> __device__ __forceinline__ void attn_load_v(KVRegs<D>& r, rsrc_t Vt, int ldv, int key0, int lane) {
    const int rho = lane & 15, quad = lane >> 4;
    const unsigned lo = (unsigned)((rho * ldv + 8 * quad) * 2);
#pragma unroll
    for (int dt = 0; dt < D / 16; ++dt) r.v[dt] = buf_ld16(Vt, lo, (unsigned)((key0 + dt * 16 * ldv) * 2));
}
template <int D> __device__ __forceinline__ void attn_scores(const AttnW<D>& w, const KVRegs<D>& r, f32x4& sa, f32x4& sb) {
    sa = (f32x4){0.f, 0.f, 0.f, 0.f}; sb = sa;
#pragma unroll
    for (int kk = 0; kk < D / 32; ++kk) { sa = MFMA16(r.ka[kk], w.q[kk], sa); sb = MFMA16(r.kb[kk], w.q[kk], sb); }
}
template <int D> __device__ __forceinline__ void attn_softmax_pv(AttnW<D>& w, const KVRegs<D>& r, const float (&s)[8]) {
    float mx = fmaxf(fmaxf(fmaxf(s[0], s[1]), fmaxf(s[2], s[3])), fmaxf(fmaxf(s[4], s[5]), fmaxf(s[6], s[7])));
    mx = rows4_max(mx);
    const float mn = fmaxf(w.m, mx); const float alpha = __builtin_amdgcn_exp2f(w.m - mn); w.m = mn;
    float p[8]; float ps = 0.f;
#pragma unroll
    for (int i = 0; i < 8; ++i) { p[i] = __builtin_amdgcn_exp2f(s[i] - mn); ps += p[i]; }
    w.l = w.l * alpha + ps;
#pragma unroll
    for (int dt = 0; dt < D / 16; ++dt) w.O[dt] = w.O[dt] * alpha;
    u32x4 pw; pw.x = cvt_pk_bf16(p[0], p[1]); pw.y = cvt_pk_bf16(p[2], p[3]); pw.z = cvt_pk_bf16(p[4], p[5]); pw.w = cvt_pk_bf16(p[6], p[7]);
    const bf16x8 pf = __builtin_bit_cast(bf16x8, pw);
#pragma unroll
    for (int dt = 0; dt < D / 16; ++dt) w.O[dt] = MFMA16(r.v[dt], pf, w.O[dt]);
}
constexpr float NEG_INF = -__builtin_huge_valf();

template <int D, class KeyF, class MaskF>
__device__ __forceinline__ void attn_stream_pv(AttnW<D>& w, rsrc_t Kb, int ldk, rsrc_t Vt, int ldv, int n, int lane, KeyF keyf, MaskF maskf) {
    if (n <= 0) return;
    KVRegs<D> ra, rb;
    int k0a = keyf(0), k0b = 0;
    attn_load_k<D>(ra, Kb, ldk, k0a, lane); attn_load_v<D>(ra, Vt, ldv, k0a, lane);
    for (int i = 0; i < n; i += 2) {
        const bool has1 = i + 1 < n;
        if (has1) { k0b = keyf(i + 1); attn_load_k<D>(rb, Kb, ldk, k0b, lane); }
        __builtin_amdgcn_sched_barrier(0);
        { f32x4 sa, sb; attn_scores<D>(w, ra, sa, sb); float s[8]; maskf(sa, sb, k0a, i, s);
          __builtin_amdgcn_sched_barrier(0);
          if (has1) attn_load_v<D>(rb, Vt, ldv, k0b, lane);
          __builtin_amdgcn_sched_barrier(0);
          attn_softmax_pv<D>(w, ra, s); }
        __builtin_amdgcn_sched_barrier(0);
        if (has1) {
            const bool has2 = i + 2 < n;
            if (has2) { k0a = keyf(i + 2); attn_load_k<D>(ra, Kb, ldk, k0a, lane); }
            __builtin_amdgcn_sched_barrier(0);
            f32x4 sa, sb; attn_scores<D>(w, rb, sa, sb); float s[8]; maskf(sa, sb, k0b, i + 1, s);
            __builtin_amdgcn_sched_barrier(0);
            if (has2) attn_load_v<D>(ra, Vt, ldv, k0a, lane);
            __builtin_amdgcn_sched_barrier(0);
            attn_softmax_pv<D>(w, rb, s);
            __builtin_amdgcn_sched_barrier(0);
        }
    }
}
template <int D> __device__ __forceinline__ void attn_band(AttnW<D>& w, rsrc_t Kb, int ldk, rsrc_t Vt, int ldv, int t0, int window, float sc, int lane) {
    const int quad = lane >> 4, tcol = t0 + ((lane >> 3) & 1);
    int lo = t0 - (window - 1); if (lo < 0) lo = 0;
    const int c0 = lo >> 5, c1 = (t0 + 1) >> 5;
    attn_stream_pv<D>(w, Kb, ldk, Vt, ldv, c1 - c0 + 1, lane, [=](int i) { return (c0 + i) * 32; }, [=](const f32x4& sa, const f32x4& sb, int k0, int, float (&s)[8]) {
        const int kb = k0 + 8 * quad;
#pragma unroll
        for (int i = 0; i < 4; ++i) { const int d0 = tcol - (kb + i), d1 = tcol - (kb + 4 + i); s[i] = ((unsigned)d0 < (unsigned)window) ? sa[i] * sc : NEG_INF; s[4 + i] = ((unsigned)d1 < (unsigned)window) ? sb[i] * sc : NEG_INF; } });
}
template <int D> __device__ __forceinline__ float attn_finish_l(const AttnW<D>& w) { return rows4_sum(w.l); }

__device__ __forceinline__ void mixer_a_task(unsigned char* ws, const float* sinks, int b, int kvh, int tp, int lane) {
    const int c = lane & 15, quad = lane >> 4, t0 = 2 * tp, tok = t0 + (c >> 3), head = kvh * 8 + (c & 7);
    const bf16* QA = (const bf16*)(ws + WS_QA); const bf16* KA = (const bf16*)(ws + WS_KA) + (size_t)b * T * 256 + kvh * 64; const bf16* VAT = (const bf16*)(ws + WS_VAT) + ((size_t)b * 256 + kvh * 64) * T;
    AttnW<64> w;
    attn_load_q<64>(w, QA + (size_t)(b * T + tok) * 2048 + head * 64, quad);
#pragma unroll
    for (int dt = 0; dt < 4; ++dt) w.O[dt] = (f32x4){0.f, 0.f, 0.f, 0.f};
    w.m = sinks[head] * LOG2E; w.l = (quad == 0) ? 1.0f : 0.0f;
    attn_band<64>(w, make_rsrc(KA), 256, make_rsrc(VAT), T, t0, AWIN, 0.125f * LOG2E, lane);
    const float inv = 1.0f / attn_finish_l<64>(w);
    bf16* orow = (bf16*)(ws + WS_OA) + (size_t)(b * T + tok) * 2048 + head * 64;
#pragma unroll
    for (int dt = 0; dt < 4; ++dt) { u32x2 o; o.x = cvt_pk_bf16(w.O[dt][0] * inv, w.O[dt][1] * inv); o.y = cvt_pk_bf16(w.O[dt][2] * inv, w.O[dt][3] * inv); *(u32x2*)(orow + 16 * dt + 4 * quad) = o; }
}
__device__ __forceinline__ void mixer_a_task4(unsigned char* ws, const float* sinks, int b, int kvh, int tq, int lane) {
    const int c = lane & 15, quad = lane >> 4, t0 = 4 * tq, head = kvh * 8 + (c & 7);
    const bf16* QA = (const bf16*)(ws + WS_QA); const bf16* KA = (const bf16*)(ws + WS_KA) + (size_t)b * T * 256 + kvh * 64; const bf16* VAT = (const bf16*)(ws + WS_VAT) + ((size_t)b * 256 + kvh * 64) * T;
    const rsrc_t Kb = make_rsrc(KA), Vt = make_rsrc(VAT);
    AttnW<64> w0, w1; const int tokA = t0 + (c >> 3), tokB = tokA + 2;
    attn_load_q<64>(w0, QA + (size_t)(b * T + tokA) * 2048 + head * 64, quad); attn_load_q<64>(w1, QA + (size_t)(b * T + tokB) * 2048 + head * 64, quad);
#pragma unroll
    for (int dt = 0; dt < 4; ++dt) { w0.O[dt] = (f32x4){0.f, 0.f, 0.f, 0.f}; w1.O[dt] = w0.O[dt]; }
    w0.m = sinks[head] * LOG2E; w0.l = (quad == 0) ? 1.0f : 0.0f; w1.m = w0.m; w1.l = w0.l;
    const float sc = 0.125f * LOG2E;
    int lo = t0 - (AWIN - 1); if (lo < 0) lo = 0;
    const int c0 = lo >> 5, c1 = (t0 + 3) >> 5, n = c1 - c0 + 1;
    auto step = [&](const KVRegs<64>& r, int k0) {
        const int kb = k0 + 8 * quad;
        { f32x4 sa, sb; attn_scores<64>(w0, r, sa, sb); float s[8];
#pragma unroll
          for (int i = 0; i < 4; ++i) { s[i] = ((unsigned)(tokA - (kb + i)) < (unsigned)AWIN) ? sa[i] * sc : NEG_INF; s[4 + i] = ((unsigned)(tokA - (kb + 4 + i)) < (unsigned)AWIN) ? sb[i] * sc : NEG_INF; }
          attn_softmax_pv<64>(w0, r, s); }
        { f32x4 sa, sb; attn_scores<64>(w1, r, sa, sb); float s[8];
#pragma unroll
          for (int i = 0; i < 4; ++i) { s[i] = ((unsigned)(tokB - (kb + i)) < (unsigned)AWIN) ? sa[i] * sc : NEG_INF; s[4 + i] = ((unsigned)(tokB - (kb + 4 + i)) < (unsigned)AWIN) ? sb[i] * sc : NEG_INF; }
          attn_softmax_pv<64>(w1, r, s); }
    };
    KVRegs<64> ra, rb;
    attn_load_k<64>(ra, Kb, 256, c0 * 32, lane); attn_load_v<64>(ra, Vt, T, c0 * 32, lane);
    for (int i = 0; i < n; i += 2) {
        const bool has1 = i + 1 < n;
        if (has1) { attn_load_k<64>(rb, Kb, 256, (c0 + i + 1) * 32, lane); attn_load_v<64>(rb, Vt, T, (c0 + i + 1) * 32, lane); }
        step(ra, (c0 + i) * 32);
        if (has1) {
            if (i + 2 < n) { attn_load_k<64>(ra, Kb, 256, (c0 + i + 2) * 32, lane); attn_load_v<64>(ra, Vt, T, (c0 + i + 2) * 32, lane); }
            step(rb, (c0 + i + 1) * 32);
        }
    }
    const float invA = 1.0f / attn_finish_l<64>(w0), invB = 1.0f / attn_finish_l<64>(w1);
    bf16* orowA = (bf16*)(ws + WS_OA) + (size_t)(b * T + tokA) * 2048 + head * 64; bf16* orowB = (bf16*)(ws + WS_OA) + (size_t)(b * T + tokB) * 2048 + head * 64;
#pragma unroll
    for (int dt = 0; dt < 4; ++dt) {
        u32x2 o; o.x = cvt_pk_bf16(w0.O[dt][0] * invA, w0.O[dt][1] * invA); o.y = cvt_pk_bf16(w0.O[dt][2] * invA, w0.O[dt][3] * invA); *(u32x2*)(orowA + 16 * dt + 4 * quad) = o;
        u32x2 p; p.x = cvt_pk_bf16(w1.O[dt][0] * invB, w1.O[dt][1] * invB); p.y = cvt_pk_bf16(w1.O[dt][2] * invB, w1.O[dt][3] * invB); *(u32x2*)(orowB + 16 * dt + 4 * quad) = p;
    }
}
__device__ __forceinline__ void gates_task(unsigned char* ws, int rt, int lane) {
    const int rho = lane & 15, quad = lane >> 4;
    const bf16* xr = (const bf16*)(ws + WS_XN) + (size_t)(rt * 16 + rho) * DM + quad * 8;
    const bf16* wg = (const bf16*)(ws + WS_WG) + (size_t)rho * DM + quad * 8;
    f32x4 acc[3];
#pragma unroll
    for (int g = 0; g < 3; ++g) acc[g] = (f32x4){0.f, 0.f, 0.f, 0.f};
#pragma unroll 1
    for (int ch = 0; ch < 32; ++ch) {
        bf16x8 xb[4], wa[3][4];
#pragma unroll
        for (int kk = 0; kk < 4; ++kk) xb[kk] = *(const bf16x8*)(xr + ch * 128 + kk * 32);
#pragma unroll
        for (int g = 0; g < 3; ++g)
#pragma unroll
            for (int kk = 0; kk < 4; ++kk) wa[g][kk] = *(const bf16x8*)(wg + (size_t)g * 16 * DM + ch * 128 + kk * 32);
#pragma unroll
        for (int g = 0; g < 3; ++g)
#pragma unroll
            for (int kk = 0; kk < 4; ++kk) acc[g] = MFMA16(wa[g][kk], xb[kk], acc[g]);
    }
    float* o = (float*)(ws + WS_SGN) + (size_t)(rt * 16 + rho) * 48 + 4 * quad;
#pragma unroll
    for (int g = 0; g < 3; ++g) { f32x4 s; for (int i = 0; i < 4; ++i) s[i] = fast_sigmoid(acc[g][i]); *(f32x4*)(o + 16 * g) = s; }
}
__device__ __forceinline__ float gelu_tanh(float x) {
    const float u = 0.7978845608028654f * (x + 0.044715f * x * x * x);
    const float e = __builtin_amdgcn_exp2f(-2.0f * LOG2E * fabsf(u)); const float th = (1.0f - e) * __builtin_amdgcn_rcpf(1.0f + e);
    return 0.5f * x * (1.0f + (u < 0.f ? -th : th));
}
__device__ __forceinline__ void compress_task(unsigned char* ws, LAS unsigned char* lds, int task, int wave, int lane) {
    const int x = task >> 7, b = (task >> 6) & 1, g = (task >> 5) & 1, c0 = (task & 31) * 16;
    const int rho = lane & 15, quad = lane >> 4;
    const bf16* src = (const bf16*)(ws + (x ? WS_VC : WS_KC)) + (size_t)b * T * 256 + g * 128 + quad * 8;
    const bf16* w1 = (const bf16*)(ws + (x ? WS_CV1 : WS_CK1)) + (size_t)rho * 4096 + quad * 8;
    f32x4 acc[8];
#pragma unroll
    for (int h = 0; h < 8; ++h) acc[h] = (f32x4){0.f, 0.f, 0.f, 0.f};
#pragma unroll 1
    for (int li = 0; li < 4; ++li) {
        const int l = wave * 4 + li; int tok = 16 * (c0 + rho) + l; if (tok > T - 1) tok = T - 1;
        bf16x8 xb[4];
#pragma unroll
        for (int kk = 0; kk < 4; ++kk) xb[kk] = *(const bf16x8*)(src + (size_t)tok * 256 + kk * 32);
#pragma unroll
        for (int hh = 0; hh < 2; ++hh) {
            bf16x8 wa[4][4];
#pragma unroll
            for (int h = 0; h < 4; ++h)
#pragma unroll
                for (int kk = 0; kk < 4; ++kk) wa[h][kk] = *(const bf16x8*)(w1 + (size_t)(hh * 4 + h) * 16 * 4096 + l * 128 + kk * 32);
#pragma unroll
            for (int h = 0; h < 4; ++h)
#pragma unroll
                for (int kk = 0; kk < 4; ++kk) acc[hh * 4 + h] = MFMA16(wa[h][kk], xb[kk], acc[hh * 4 + h]);
        }
    }
    LAS float* part = (LAS float*)lds;
    LAS bf16* g2 = (LAS bf16*)(lds + 65536);
#pragma unroll
    for (int h = 0; h < 8; ++h)
#pragma unroll
        for (int i = 0; i < 4; ++i) part[(wave * 128 + 16 * h + 4 * quad + i) * 16 + rho] = acc[h][i];
    __syncthreads();
    {
        const float* cbp = (const float*)(ws + WS_CBP) + x * 16 * 128;
        float hv[4];
#pragma unroll
        for (int i = 0; i < 4; ++i) { const int hid = 16 * wave + 4 * quad + i; float s = 0.f;
#pragma unroll
            for (int pw = 0; pw < 8; ++pw) s += part[(pw * 128 + hid) * 16 + rho];
            float bsum = 0.f;
#pragma unroll
            for (int kc = 0; kc < 16; ++kc) bsum += cbp[kc * 128 + hid];
            hv[i] = gelu_tanh(s + bsum); }
        u32x2 o; o.x = cvt_pk_bf16(hv[0], hv[1]); o.y = cvt_pk_bf16(hv[2], hv[3]);
        *(LAS u32x2*)(g2 + rho * 128 + 16 * wave + 4 * quad) = o;
    }
    __syncthreads();
    {
        const bf16* w2 = (const bf16*)(ws + (x ? WS_CV2 : WS_CK2)) + (size_t)(16 * wave + rho) * 128 + 8 * quad;
        f32x4 o = (f32x4){0.f, 0.f, 0.f, 0.f};
#pragma unroll
        for (int s = 0; s < 4; ++s) { const bf16x8 a = *(const bf16x8*)(w2 + 32 * s); const bf16x8 bb = *(const LAS bf16x8*)(g2 + rho * 128 + 32 * s + 8 * quad); o = MFMA16(a, bb, o); }
        const int c = c0 + rho, d0 = 16 * wave + 4 * quad;
        if (x == 0) { bf16* kc = (bf16*)(ws + WS_KCMP) + ((size_t)(b * 2 + g) * NCP + c) * 128 + d0; u32x2 p; p.x = cvt_pk_bf16(o[0], o[1]); p.y = cvt_pk_bf16(o[2], o[3]); *(u32x2*)kc = p; }
        else { bf16* vc = (bf16*)(ws + WS_VCMPT) + ((size_t)(b * 2 + g) * 128 + d0) * NCP + c;
#pragma unroll
            for (int i = 0; i < 4; ++i) vc[(size_t)i * NCP] = (bf16)(cvt_pk_bf16(o[i], 0.f) & 0xffffu); }
    }
    __syncthreads();
}

constexpr int G_TOK = 14, G_NCONS = 7, G_SLOTS = 4, G_SLOT_BYTES = 32768, G_NGROUP = (T + G_TOK - 1) / G_TOK;
#ifndef G_VPRE
#define G_VPRE 14
#endif
constexpr int GX_OFF = 131072 + 512;
constexpr int GX_DESC = GX_OFF, GX_NDESC = 192;
constexpr int GX_CTL = GX_DESC + GX_NDESC * 4;
constexpr int GX_TAB = GX_CTL + 128;
constexpr int GX_WAVE = GX_TAB + 64, GX_WAVE_BYTES = 1152;
static_assert(GX_WAVE + 8 * GX_WAVE_BYTES <= 147456, "P6 LDS map");
constexpr float G_THR = 8.0f;
constexpr unsigned G_SPIN_CAP = 1u << 22;
__device__ __forceinline__ unsigned g_lds_ld(unsigned addr) { unsigned v; asm volatile("ds_read_b32 %0, %1\n\ts_waitcnt lgkmcnt(0)" : "=v"(v) : "v"(addr) : "memory"); return v; }
__device__ __forceinline__ void g_lds_st(unsigned addr, unsigned v) { asm volatile("ds_write_b32 %0, %1" :: "v"(addr), "v"(v) : "memory"); }
__device__ __forceinline__ void g_wait_ge(unsigned addr, unsigned want, unsigned tmo_addr) {
    unsigned sp = 0;
    while ((unsigned)__builtin_amdgcn_readfirstlane((int)g_lds_ld(addr)) < want) { __builtin_amdgcn_s_sleep(1); ++sp; if ((sp & 1023u) == 0u && __builtin_amdgcn_readfirstlane((int)g_lds_ld(tmo_addr)) != 0) break; if (sp > G_SPIN_CAP) { g_lds_st(tmo_addr, 1u); break; } }
}
__device__ __forceinline__ void nsa_group_task(unsigned char* ws, LAS unsigned char* lds, int b, int g, int tg, int wave, int lane, const int crip) {
    asm volatile("" : "+v"(lane));
    const int t0 = G_TOK * tg;
    LAS unsigned* desc = (LAS unsigned*)(lds + GX_DESC);
    volatile LAS unsigned* gctl = (volatile LAS unsigned*)(lds + GX_CTL);
    const unsigned A_CTL = (unsigned)(size_t)(lds + GX_CTL);
    const int ntok = (T - t0) < G_TOK ? (T - t0) : G_TOK, nact = (ntok + 1) >> 1;
    const int tlast = t0 + ntok - 1;
    const int nvmax = tlast >= 31 ? ((tlast - 31) >> 4) + 1 : 0; int ncmp = (nvmax + 63) >> 6; if (ncmp < 1) ncmp = 1;
    int wlo = t0 - (BWIN - 1); if (wlo < 0) wlo = 0; const int wc0 = wlo >> 6, wc1 = tlast >> 6, nwin = wc1 - wc0 + 1;
    const int nfix = 2 * ncmp + nwin;
    for (int i = threadIdx.x; i < nfix; i += NWAVES * 64) {
        unsigned d;
        if (i < ncmp) d = 0u | ((unsigned)(i * 64) << 8) | (i == ncmp - 1 ? 4u : 0u);
        else if (i < 2 * ncmp) d = 1u | ((unsigned)((i - ncmp) * 64) << 8) | (i == 2 * ncmp - 1 ? 4u : 0u);
        else d = 2u | ((unsigned)((wc0 + i - 2 * ncmp) * 64) << 8) | (i == nfix - 1 ? 4u : 0u);
        desc[i] = d;
    }
    if (threadIdx.x < 32 && threadIdx.x != 1) gctl[threadIdx.x] = (threadIdx.x == 0) ? (unsigned)nfix : (threadIdx.x >= 16 + nact && threadIdx.x < 16 + G_NCONS) ? 0x7fffffffu : 0u;
    if (threadIdx.x >= 64 && threadIdx.x < 72) {
        const int e = threadIdx.x - 64, kd = e >> 1; const bool isv = e & 1; size_t a;
        if (kd < 2) a = isv ? WS_VCMPT + (size_t)(b * 2 + g) * 128 * NCP * 2 : WS_KCMP + (size_t)(b * 2 + g) * NCP * 128 * 2;
        else if (kd == 2) a = isv ? WS_VWT + ((size_t)b * 256 + g * 128) * T * 2 : WS_KW + ((size_t)b * T * 256 + g * 128) * 2;
        else a = isv ? WS_VST + ((size_t)b * 256 + g * 128) * T * 2 : WS_KS + ((size_t)b * T * 256 + g * 128) * 2;
        ((LAS unsigned long long*)(lds + GX_TAB))[e] = (unsigned long long)(size_t)(ws + a);
    }
    if (wave < G_NCONS) { LAS float* impz = (LAS float*)(lds + GX_WAVE + wave * GX_WAVE_BYTES); for (int i = lane; i < 2 * 136; i += 64) impz[i] = 0.f; }
    LDS_WAIT(); __builtin_amdgcn_s_barrier(); asm volatile("" ::: "memory");
    if (wave >= G_NCONS) {
        const int rho = lane & 15, quad = lane >> 4;
        const unsigned A_RDK = A_CTL + 4 * 2, A_RDV = A_CTL + 4 * 3;
        __builtin_amdgcn_s_setprio(3);
        int nk = nfix, j = 0; bool slc_known = false;
        for (;;) {
            if (j >= nk) {
                asm volatile("s_waitcnt vmcnt(0)" ::: "memory"); g_lds_st(A_RDK, (unsigned)j); g_lds_st(A_RDV, (unsigned)j);
                if (slc_known) break;
                g_wait_ge(A_CTL + 4 * 9, 1u, A_CTL + 4 * 10); nk = __builtin_amdgcn_readfirstlane((int)g_lds_ld(A_CTL)); slc_known = true;
                if (j >= nk) break;
            }
            if (j >= G_SLOTS) {
                const unsigned want = (unsigned)(j - G_SLOTS + 1);
                u32x4 p0, p1;
                asm volatile("ds_read_b128 %0, %2 offset:64\n\tds_read_b128 %1, %2 offset:80\n\ts_waitcnt lgkmcnt(0)" : "=&v"(p0), "=&v"(p1) : "v"(A_CTL) : "memory");
                unsigned mn = p0.x < p0.y ? p0.x : p0.y; { const unsigned m2 = p0.z < p0.w ? p0.z : p0.w; mn = mn < m2 ? mn : m2; } { const unsigned m3 = p1.x < p1.y ? p1.x : p1.y; mn = mn < m3 ? mn : m3; } mn = mn < p1.z ? mn : p1.z;
                if ((unsigned)__builtin_amdgcn_readfirstlane((int)mn) < want) { asm volatile("s_waitcnt vmcnt(0)" ::: "memory"); g_lds_st(A_RDK, (unsigned)j); g_lds_st(A_RDV, (unsigned)j);
#pragma unroll
                    for (int w = 0; w < G_NCONS; ++w) g_wait_ge(A_CTL + 4 * (16 + w), want, A_CTL + 4 * 10); }
            }
            const unsigned d = (unsigned)__builtin_amdgcn_readfirstlane((int)desc[j]); const int kind = (int)(d & 3u), key0 = (int)(d >> 8);
            const LAS unsigned long long* tab = (const LAS unsigned long long*)(lds + GX_TAB);
            LAS unsigned char* slot = lds + (j & (G_SLOTS - 1)) * G_SLOT_BYTES;
            if (!((crip & 2) && kind >= 2)) {
                const int ldk = kind < 2 ? 128 : 256;
                const bf16* src = (const bf16*)(size_t)tab[2 * kind] + (size_t)(key0 + 8 * (rho >> 2) + (rho & 3)) * ldk + quad * 8;
#pragma unroll
                for (int tl = 0; tl < 4; ++tl)
#pragma unroll
                    for (int kk = 0; kk < 4; ++kk) __builtin_amdgcn_global_load_lds((const unsigned*)(src + (size_t)(32 * (tl >> 1) + 4 * (tl & 1)) * ldk + 32 * kk), (LAS unsigned*)(slot + (tl * 4 + kk) * 1024), 16, 0, 0);
            }
            __builtin_amdgcn_s_sleep(2);
            if (!(crip & 2) && kind != 1) {
                const int ldv = kind < 2 ? NCP : T;
                const bf16* src = (const bf16*)(size_t)tab[2 * kind + 1] + (size_t)rho * ldv + key0 + 8 * quad;
#pragma unroll
                for (int dt = 0; dt < 8; ++dt) {
                    __builtin_amdgcn_global_load_lds((const unsigned*)(src + (size_t)dt * 16 * ldv), (LAS unsigned*)(slot + (16 + 2 * dt) * 1024), 16, 0, 0);
                    __builtin_amdgcn_global_load_lds((const unsigned*)(src + (size_t)dt * 16 * ldv + 32), (LAS unsigned*)(slot + (17 + 2 * dt) * 1024), 16, 0, 0);
                }
            }
            ++j;
            __builtin_amdgcn_s_sleep(1);
            if (j >= 2) { if (kind == 1) asm volatile("s_waitcnt vmcnt(16)" ::: "memory"); else asm volatile("s_waitcnt vmcnt(32)" ::: "memory");
                          g_lds_st(A_RDK, (unsigned)(j - 1)); g_lds_st(A_RDV, (unsigned)(j - 1)); }
        }
        __builtin_amdgcn_s_setprio(0);
    } else if (wave < nact) {
        const int c = lane & 15, quad = lane >> 4, tau = c >> 3, tw0 = t0 + 2 * wave, head = g * 8 + (c & 7);
        int tok = tw0 + tau; const bool tok_ok = tok < T; if (!tok_ok) tok = T - 1;
        const size_t row = (size_t)b * T + tok;
        LAS float* imp = (LAS float*)(lds + GX_WAVE + wave * GX_WAVE_BYTES);
        LAS unsigned* selmask = (LAS unsigned*)(lds + GX_WAVE + wave * GX_WAVE_BYTES + 1088);
        const float sc = 0.08838834764831845f * LOG2E;
        const float* sg0 = (const float*)(ws + WS_SGN) + row * 48 + head * 3;
        bf16x8 q[4]; f32x4 O[8], Of[8]; float m = -1e30f, l = 0.f, mfin = 0.f, invc = 0.f;
        { const bf16* qrow = (const bf16*)(ws + WS_QB0) + row * 2048 + head * 128;
#pragma unroll
          for (int kk = 0; kk < 4; ++kk) q[kk] = *(const bf16x8*)(qrow + kk * 32 + quad * 8); }
        const float g_cmp = sg0[0], g_slc = sg0[1], g_win = sg0[2];
#pragma unroll
        for (int dt = 0; dt < 8; ++dt) { O[dt] = (f32x4){0.f, 0.f, 0.f, 0.f}; Of[dt] = O[dt]; }
        const int nvis = tok >= 31 ? ((tok - 31) >> 4) + 1 : 0;
        int nk = nfix; bool slc_known = false;
        unsigned smw[8] = {0u, 0u, 0u, 0u, 0u, 0u, 0u, 0u};
        unsigned dnext = (unsigned)__builtin_amdgcn_readfirstlane((int)desc[0]);
        for (int idx = 0;; ++idx) {
            if (idx >= nk) { if (slc_known) break; g_wait_ge(A_CTL + 4 * 9, 1u, A_CTL + 4 * 10); nk = __builtin_amdgcn_readfirstlane((int)g_lds_ld(A_CTL)); slc_known = true; if (idx >= nk) break; dnext = (unsigned)__builtin_amdgcn_readfirstlane((int)desc[idx]); }
            const unsigned d = dnext; const int kind = (int)(d & 3u), key0 = (int)(d >> 8);
            const int kb = key0 + 8 * quad;
            bool need = true; unsigned sm0 = 0u, sm1 = 0u;
            if (kind == 2) need = (key0 <= tw0 + 1) && (key0 + 63 >= tw0 - (BWIN - 1));
            else if (kind == 3) { const int j = key0 >> 6, jw = j >> 5; const unsigned w0 = jw == 0 ? smw[0] : jw == 1 ? smw[1] : jw == 2 ? smw[2] : smw[3], w1 = jw == 0 ? smw[4] : jw == 1 ? smw[5] : jw == 2 ? smw[6] : smw[7]; sm0 = (w0 >> (j & 31)) & 1u; sm1 = (w1 >> (j & 31)) & 1u; need = (sm0 | sm1) != 0u; }
            if ((crip & 1) && kind >= 2) need = false;
            if (need) {
                const LAS unsigned char* slot = lds + (idx & (G_SLOTS - 1)) * G_SLOT_BYTES + lane * 16;
                g_wait_ge(A_CTL + 4 * 3, (unsigned)idx + 1u, A_CTL + 4 * 10);
                f32x4 sv[4];
                {
                    bf16x8 kf[16];
#pragma unroll
                    for (int kk = 0; kk < 4; ++kk)
#pragma unroll
                        for (int tl = 0; tl < 4; ++tl) kf[kk * 4 + tl] = *(const LAS bf16x8*)(slot + (tl * 4 + kk) * 1024);
                    __builtin_amdgcn_sched_barrier(0);
#pragma unroll
                    for (int tl = 0; tl < 4; ++tl) sv[tl] = (f32x4){0.f, 0.f, 0.f, 0.f};
#pragma unroll
                    for (int kk = 0; kk < 4; ++kk)
#pragma unroll
                        for (int tl = 0; tl < 4; ++tl) sv[tl] = MFMA16(kf[kk * 4 + tl], q[kk], sv[tl]);
                    __builtin_amdgcn_sched_barrier(0);
                }
                if (kind == 1) {
#pragma unroll
                    for (int h = 0; h < 2; ++h) {
                        float p[8]; const int kh = kb + 32 * h;
#pragma unroll
                        for (int i = 0; i < 4; ++i) { p[i] = (kh + i < nvis) ? __builtin_amdgcn_exp2f(sv[2 * h][i] * sc - mfin) * invc : 0.f; p[4 + i] = (kh + 4 + i < nvis) ? __builtin_amdgcn_exp2f(sv[2 * h + 1][i] * sc - mfin) * invc : 0.f; }
                        float A = p[0], B = p[0] + 2.f * (p[1] + p[2] + p[3]) + p[4], C = p[4] + 2.f * (p[5] + p[6] + p[7]);
                        A = heads8_sum(A); B = heads8_sum(B); C = heads8_sum(C);
                        if ((lane & 7) == 0) { LAS float* ip = imp + tau * 136 + (kh >> 2); __hip_atomic_fetch_add(ip, A, __ATOMIC_RELAXED, __HIP_MEMORY_SCOPE_WORKGROUP); __hip_atomic_fetch_add(ip + 1, B, __ATOMIC_RELAXED, __HIP_MEMORY_SCOPE_WORKGROUP); __hip_atomic_fetch_add(ip + 2, C, __ATOMIC_RELAXED, __HIP_MEMORY_SCOPE_WORKGROUP); }
                    }
                } else {
                    bf16x8 vf[16];
#pragma unroll
                    for (int i = 0; i < G_VPRE; ++i) vf[i] = *(const LAS bf16x8*)(slot + (16 + 2 * (i & 7) + (i >> 3)) * 1024);
                    __builtin_amdgcn_sched_barrier(0);
                    float s[16];
                    const int lim = kind == 0 ? nvis - 1 : tok;
                    const unsigned span = kind == 0 ? 0x7fffffffu : kind == 2 ? (unsigned)BWIN : (((tau ? sm1 : sm0) != 0u) ? 0x7fffffffu : 0u);
                    if (!__all(((unsigned)(lim - key0) < span) && ((unsigned)(lim - (key0 + 63)) < span))) {
#pragma unroll
                        for (int h = 0; h < 2; ++h)
#pragma unroll
                            for (int i = 0; i < 4; ++i) {
                                const int k0_ = kb + 32 * h + i, k1_ = k0_ + 4;
                                sv[2 * h][i] = ((unsigned)(lim - k0_) < span) ? sv[2 * h][i] : NEG_INF; sv[2 * h + 1][i] = ((unsigned)(lim - k1_) < span) ? sv[2 * h + 1][i] : NEG_INF;
                            }
                    }
                    float mx = sv[0][0];
#pragma unroll
                    for (int tl = 0; tl < 4; ++tl)
#pragma unroll
                        for (int i = 0; i < 4; ++i) mx = fmaxf(mx, sv[tl][i]);
                    mx *= sc;
#if MK_PERMCHK
                    { const float mref = fmaxf(fmaxf(mx, __shfl_xor(mx, 16)), fmaxf(__shfl_xor(mx, 32), __shfl_xor(mx, 48))); const float mnew = rows4_max(mx); const float sref = (mx + __shfl_xor(mx, 16)) + (__shfl_xor(mx, 32) + __shfl_xor(mx, 48)); const float snew = rows4_sum(mx);
                      const bool fin = mref < 1e30f && fminf(fminf(mx, __shfl_xor(mx, 16)), fminf(__shfl_xor(mx, 32), __shfl_xor(mx, 48))) > -1e30f; const bool bad = !(mref == mnew) || (fin && !(fabsf(sref - snew) <= 1e-5f * fabsf(sref) + 1e-30f));
                      if (__any(bad) && lane == 0) atomicOr((unsigned*)(ws + WS_CTL) + 32768 + 64 * 20, 1u); }
#endif
                    mx = rows4_max(mx);
                    {
                        const float mn = (mx > m + G_THR) ? mx : m; const float alpha = __builtin_amdgcn_exp2f(m - mn); m = mn; l *= alpha;
#pragma unroll
                        for (int dt = 0; dt < 8; ++dt) O[dt] = O[dt] * alpha;
                    }
                    float ps = 0.f;
#pragma unroll
                    for (int i = 0; i < 16; ++i) { s[i] = __builtin_amdgcn_exp2f(__builtin_fmaf(sv[2 * (i >> 3) + ((i >> 2) & 1)][i & 3], sc, -m)); ps += s[i]; }
                    l += ps;
                    __builtin_amdgcn_sched_barrier(0);
#pragma unroll
                    for (int i = G_VPRE; i < 16; ++i) vf[i] = *(const LAS bf16x8*)(slot + (16 + 2 * (i & 7) + (i >> 3)) * 1024);
                    __builtin_amdgcn_sched_barrier(0);
#pragma unroll
                    for (int h = 0; h < 2; ++h) {
                        u32x4 pw; pw.x = cvt_pk_bf16(s[8 * h + 0], s[8 * h + 1]); pw.y = cvt_pk_bf16(s[8 * h + 2], s[8 * h + 3]); pw.z = cvt_pk_bf16(s[8 * h + 4], s[8 * h + 5]); pw.w = cvt_pk_bf16(s[8 * h + 6], s[8 * h + 7]);
                        const bf16x8 pf = __builtin_bit_cast(bf16x8, pw);
#pragma unroll
                        for (int dt = 0; dt < 8; ++dt) O[dt] = MFMA16(vf[h * 8 + dt], pf, O[dt]);
                    }
                }
            }
            LDS_WAIT(); g_lds_st(A_CTL + 4 * (16 + wave), (unsigned)idx + 1u);
            if (idx + 1 < nk) dnext = (unsigned)__builtin_amdgcn_readfirstlane((int)desc[idx + 1]);
            if (d & 4u) {
                if (kind != 1) {
                    const float lt = rows4_sum(l);
                    const float inv = lt > 0.f ? 1.0f / lt : 0.f;
                    if (kind == 0) { mfin = m; invc = inv; }
                    const float gs = (kind == 0 ? g_cmp : kind == 2 ? g_win : g_slc) * inv;
#pragma unroll
                    for (int dt = 0; dt < 8; ++dt) { Of[dt] = Of[dt] + O[dt] * gs; O[dt] = (f32x4){0.f, 0.f, 0.f, 0.f}; }
                    m = -1e30f; l = 0.f;
                } else {
                    LDS_WAIT();
                    int ln = lane; asm volatile("" : "+v"(ln));
                    bf16x8 q2[4];
                    { int tk2 = tw0 + ((ln & 15) >> 3); if (tk2 > T - 1) tk2 = T - 1;
                      const bf16* qrow2 = (const bf16*)(ws + WS_QBR) + ((size_t)b * T + tk2) * 2048 + (g * 8 + (ln & 7)) * 128 + (ln >> 4) * 8;
#pragma unroll
                      for (int kk = 0; kk < 4; ++kk) q2[kk] = *(const bf16x8*)(qrow2 + kk * 32); }
                    {
                        int tt = tw0 + (ln >> 5); if (tt > T - 1) tt = T - 1; const int cur = tt >> 6, l5 = ln & 31; const LAS float* ip = imp + (ln >> 5) * 136;
                        unsigned key[4];
#pragma unroll
                        for (int e = 0; e < 4; ++e) { const int j = l5 + 32 * e; const bool forced = (j == 0) | (j == cur) | (j == cur - 1); const unsigned v = forced ? 0x7f800000u : __float_as_uint(ip[j]);
                            key[e] = (j <= cur) ? ((v & ~0x7fu) | (unsigned)(127 - j)) : 0u; }
                        unsigned mw[4] = {0u, 0u, 0u, 0u};
#pragma unroll
                        for (int r = 0; r < NSEL; ++r) {
                            unsigned best = key[0] > key[1] ? key[0] : key[1]; { const unsigned b2 = key[2] > key[3] ? key[2] : key[3]; best = best > b2 ? best : b2; }
                            best = half32_umax(best);
                            if (best != 0u) {
                                const int j = 127 - (int)(best & 0x7fu);
#pragma unroll
                                for (int e = 0; e < 4; ++e) { if (key[e] == best) key[e] = 0u; if ((j >> 5) == e) mw[e] |= 1u << (j & 31); }
                            }
                        }
                        if (l5 == 0) {
#pragma unroll
                            for (int e = 0; e < 4; ++e) { selmask[(ln >> 5) * 4 + e] = mw[e]; __hip_atomic_fetch_or((LAS unsigned*)(lds + GX_CTL) + 4 + e, mw[e], __ATOMIC_RELAXED, __HIP_MEMORY_SCOPE_WORKGROUP); }
                        }
                    }
                    LDS_WAIT();
#pragma unroll
                    for (int e = 0; e < 8; ++e) smw[e] = (unsigned)__builtin_amdgcn_readfirstlane((int)selmask[e]);
                    if (ln == 0) __hip_atomic_fetch_add((LAS unsigned*)(lds + GX_CTL) + 8, 1u, __ATOMIC_RELAXED, __HIP_MEMORY_SCOPE_WORKGROUP);
                    if (wave == 0) {
                        g_wait_ge(A_CTL + 4 * 8, (unsigned)nact, A_CTL + 4 * 10);
                        const unsigned u0 = gctl[4], u1 = gctl[5], u2 = gctl[6], u3 = gctl[7];
                        const int base = nfix;
                        const int cnt = __popc(u0) + __popc(u1) + __popc(u2) + __popc(u3);
#pragma unroll
                        for (int e = 0; e < 2; ++e) {
                            const int j = ln + 64 * e; const unsigned w_ = (j >> 5) == 0 ? u0 : (j >> 5) == 1 ? u1 : (j >> 5) == 2 ? u2 : u3;
                            if ((w_ >> (j & 31)) & 1u) {
                                int r = __popc(w_ & ((1u << (j & 31)) - 1u));
                                if ((j >> 5) > 0) r += __popc(u0); if ((j >> 5) > 1) r += __popc(u1); if ((j >> 5) > 2) r += __popc(u2);
                                desc[base + r] = 3u | ((unsigned)(64 * j) << 8) | (r == cnt - 1 ? 4u : 0u);
                            }
                        }
                        LDS_WAIT();
                        if (ln == 0) { gctl[0] = (unsigned)(base + cnt); }
                        LDS_WAIT();
                        if (ln == 0) { gctl[9] = 1u; }
                        LDS_WAIT();
                    }
#pragma unroll
                    for (int kk = 0; kk < 4; ++kk) q[kk] = q2[kk];
                }
            }
        }
        if (tok_ok && !crip) {
            int ln = lane; asm volatile("" : "+v"(ln));
            int tk2 = tw0 + ((ln & 15) >> 3); if (tk2 > T - 1) tk2 = T - 1;
            bf16* orow = (bf16*)(ws + WS_OB) + ((size_t)b * T + tk2) * 2048 + (g * 8 + (ln & 7)) * 128 + 4 * (ln >> 4);
#pragma unroll
            for (int dt = 0; dt < 8; ++dt) { u32x2 p; p.x = cvt_pk_bf16(Of[dt][0], Of[dt][1]); p.y = cvt_pk_bf16(Of[dt][2], Of[dt][3]); *(u32x2*)(orow + 16 * dt) = p; }
        }
    }
    asm volatile("s_waitcnt vmcnt(0) lgkmcnt(0)" ::: "memory"); __builtin_amdgcn_s_barrier(); asm volatile("" ::: "memory");
}

#ifndef MK_CHECK
#define MK_CHECK 0
#define MK_CHECK_BIT 0
#define MK_CHECK_TOTAL 8192
#endif
constexpr int CW_DBG = 32768;
__device__ __forceinline__ float bf2f(bf16 v) { return __uint_as_float(((unsigned)v) << 16); }
__device__ __forceinline__ unsigned hash_u(unsigned x) { x ^= x >> 16; x *= 0x7feb352du; x ^= x >> 15; x *= 0x846ca68bu; x ^= x >> 16; return x; }
__device__ __forceinline__ float dot_bf(const bf16* a, const bf16* b, int n, int lane) { float s = 0.f; for (int k = lane; k < n; k += 64) s += bf2f(a[k]) * bf2f(b[k]); return wave_sum(s); }
__device__ __forceinline__ void dbg_flag(unsigned* ctl, int bit, bool bad, int lane) { if (bad && lane == 0) atomicAdd(ctl + CW_DBG + 64 * bit, 1u); }
__device__ __forceinline__ void dbg_after_p4(unsigned char* ws, unsigned* ctl, const int* pos, int gw, int NGW, int lane) {
    const bf16* XN = (const bf16*)(ws + WS_XN); const bf16* WIN = (const bf16*)(ws + WS_WIN);
    for (int s = gw; s < 8192; s += NGW) {
        const unsigned h = hash_u((unsigned)s * 2654435761u + 12345u); const int row = (int)(h % M); const unsigned h2 = hash_u(h + 77u);
        const int b = row / T, t = row % T;
        {
            const int col = (int)(h2 % 8192u), which = col >> 12, cc = col & 4095;
            const float d = dot_bf(XN + (size_t)row * DM, WIN + (size_t)(6144 + which * 4096 + cc) * DM, DM, lane);
            const float ref = 1.f / (1.f + expf(-d)); const float got = bf2f(((const bf16*)(ws + (which ? WS_SGB : WS_SGA)))[(size_t)row * DM + cc]);
            const bool badg = !(fabsf(ref - got) < 0.02f);
            dbg_flag(ctl, 0, badg, lane);
            dbg_flag(ctl, 7, !(got >= -0.01f && got <= 1.01f), lane);
            if (lane == 0) atomicMax(ctl + CW_DBG + 64 * 12, __float_as_uint(fabsf(ref - got)));
            if (badg && lane == 0) { const float xv = bf2f(XN[(size_t)row * DM + cc]); unsigned hm = 0; if (fabsf(got - d) < 0.05f) hm |= 1; if (got == xv) hm |= 2; if (fabsf(got) < 1e-6f) hm |= 4; if (got >= 0.f && got <= 1.f) hm |= 8; if (got == 65536.f) hm |= 16; if (which) hm |= 32; atomicAnd(ctl + CW_DBG + 64 * 13, hm); atomicOr(ctl + CW_DBG + 64 * 14, hm); }
            if (badg && lane == 0) { const unsigned prop = (unsigned)(col & 255) | ((unsigned)(row & 255) << 8) | ((unsigned)((col >> 8) & 31) << 16) | ((unsigned)(row >> 8) << 21); atomicAnd(ctl + CW_DBG + 64 * 10, prop); atomicOr(ctl + CW_DBG + 64 * 11, prop); }
        }
        {
            const int cc = (int)(h2 % 256u);
            float d = dot_bf(XN + (size_t)row * DM, WIN + (size_t)(4608 + cc) * DM, DM, lane); float got = bf2f(((const bf16*)(ws + WS_KC))[(size_t)row * 256 + cc]);
            bool bad = !(fabsf(d - got) < 0.03f + 0.02f * fabsf(d));
            d = dot_bf(XN + (size_t)row * DM, WIN + (size_t)(4864 + cc) * DM, DM, lane); got = bf2f(((const bf16*)(ws + WS_VC))[(size_t)row * 256 + cc]);
            bad |= !(fabsf(d - got) < 0.03f + 0.02f * fabsf(d));
            d = dot_bf(XN + (size_t)row * DM, WIN + (size_t)(2304 + cc) * DM, DM, lane); got = bf2f(((const bf16*)(ws + WS_VAT))[((size_t)b * 256 + cc) * T + t]);
            bad |= !(fabsf(d - got) < 0.03f + 0.02f * fabsf(d));
            d = dot_bf(XN + (size_t)row * DM, WIN + (size_t)(5376 + cc) * DM, DM, lane); got = bf2f(((const bf16*)(ws + WS_VST))[((size_t)b * 256 + cc) * T + t]);
            bad |= !(fabsf(d - got) < 0.03f + 0.02f * fabsf(d));
            d = dot_bf(XN + (size_t)row * DM, WIN + (size_t)(5888 + cc) * DM, DM, lane); got = bf2f(((const bf16*)(ws + WS_VWT))[((size_t)b * 256 + cc) * T + t]);
            bad |= !(fabsf(d - got) < 0.03f + 0.02f * fabsf(d));
            const int hc = (int)(h2 % 2048u);
            d = dot_bf(XN + (size_t)row * DM, WIN + win_row_off(2560 + hc), DM, lane); got = bf2f(((const bf16*)(ws + WS_QB0))[(size_t)row * 2048 + hc]);
            bad |= !(fabsf(d - got) < 0.03f + 0.02f * fabsf(d));
            dbg_flag(ctl, 1, bad, lane);
        }
        {
            const int g = (int)(h2 & 1u), p = (int)((h2 >> 1) & 127u), q = p >> 3, e = p & 7, fi = 4 * q + (e & 3);
            const float x1 = dot_bf(XN + (size_t)row * DM, WIN + win_row_off(5120 + g * 128 + fi), DM, lane), x2 = dot_bf(XN + (size_t)row * DM, WIN + win_row_off(5120 + g * 128 + 64 + fi), DM, lane);
            double inv = 1.0; for (int i = 0; i < fi; ++i) inv *= 0.8659643233600653524; const double ang = (double)pos[row] * inv; const float cs = (float)cos(ang), sn = (float)sin(ang);
            const float ref = e < 4 ? x1 * cs - x2 * sn : x2 * cs + x1 * sn; const float got = bf2f(((const bf16*)(ws + WS_KS))[(size_t)row * 256 + g * 128 + p]);
            bool bad = !(fabsf(ref - got) < 0.03f + 0.02f * fabsf(ref));
            const int kvh = (int)((h2 >> 8) & 3u), p6 = (int)((h2 >> 10) & 63u), q6 = p6 >> 3, e6 = p6 & 7, f6 = 4 * q6 + (e6 & 3);
            const float y1 = dot_bf(XN + (size_t)row * DM, WIN + win_row_off(2048 + kvh * 64 + f6), DM, lane), y2 = dot_bf(XN + (size_t)row * DM, WIN + win_row_off(2048 + kvh * 64 + 32 + f6), DM, lane);
            double inv6 = 1.0; for (int i = 0; i < f6; ++i) inv6 *= 0.7498942093324558273; const double a6 = (double)pos[row] * inv6; const float c6 = (float)cos(a6), s6 = (float)sin(a6);
            const float r6 = e6 < 4 ? y1 * c6 - y2 * s6 : y2 * c6 + y1 * s6; const float g6 = bf2f(((const bf16*)(ws + WS_KA))[(size_t)row * 256 + kvh * 64 + p6]);
            bad |= !(fabsf(r6 - g6) < 0.03f + 0.02f * fabsf(r6));
            dbg_flag(ctl, 2, bad, lane);
        }
    }
}
__device__ __forceinline__ void dbg_after_p5(unsigned char* ws, unsigned* ctl, const float* sinks, const float* pe_k, const float* pe_v, const float* w1k, const float* w1v, int gw, int NGW, int lane) {
    for (int s = gw; s < 4096; s += NGW) {
        const unsigned h = hash_u((unsigned)s * 2654435761u + 999u); const int row = (int)(h % M); const int b = row / T, t = row % T; const int head = (int)(hash_u(h + 5u) % 32u), kvh = head >> 3;
        {
            const bf16* q = (const bf16*)(ws + WS_QA) + (size_t)row * 2048 + head * 64; const int lo = t - 127 < 0 ? 0 : t - 127;
            float sc[2];
#pragma unroll
            for (int i = 0; i < 2; ++i) { const int key = lo + lane + 64 * i; float d = -INFINITY; if (key <= t) { const bf16* k = (const bf16*)(ws + WS_KA) + ((size_t)b * T + key) * 256 + kvh * 64; d = 0.f; for (int p = 0; p < 64; ++p) d += bf2f(q[p]) * bf2f(k[p]); d *= 0.125f; } sc[i] = d; }
            float m = fmaxf(fmaxf(sc[0], sc[1]), sinks[head]);
#pragma unroll
            for (int o = 1; o < 64; o <<= 1) m = fmaxf(m, __shfl_xor(m, o));
            const float e0 = expf(sc[0] - m), e1 = expf(sc[1] - m); const float den = wave_sum(e0 + e1) + expf(sinks[head] - m);
            float o = 0.f; const bf16* v = (const bf16*)(ws + WS_VAT) + ((size_t)b * 256 + kvh * 64 + lane) * T;
            for (int kk = 0; kk < 128; ++kk) { const int key = lo + kk; const float p = __shfl(kk < 64 ? e0 : e1, kk & 63); if (key <= t) o += p * bf2f(v[key]); }
            o /= den; const float got = bf2f(((const bf16*)(ws + WS_OA))[(size_t)row * 2048 + head * 64 + lane]);
            const bool bad = !(fabsf(o - got) < 0.02f + 0.03f * fabsf(o));
            dbg_flag(ctl, 3, __any(bad), lane);
        }
    }
    for (int s = gw; s < 512; s += NGW) {
        const unsigned h = hash_u((unsigned)s * 2654435761u + 4242u); const int x = h & 1, b = (h >> 1) & 1, g = (h >> 2) & 1, c = (int)((h >> 3) % 511u), dout = (int)((h >> 12) & 127u);
        const bf16* src = (const bf16*)(ws + (x ? WS_VC : WS_KC)) + (size_t)b * T * 256 + g * 128; const bf16* w1 = (const bf16*)(ws + (x ? WS_CV1 : WS_CK1)); const bf16* w2 = (const bf16*)(ws + (x ? WS_CV2 : WS_CK2));
        const float* pe = x ? pe_v : pe_k; const float* w1f = x ? w1v : w1k;
        float acc = 0.f;
        for (int hid = 0; hid < 128; ++hid) {
            float d = 0.f;
            for (int k = lane; k < 4096; k += 64) { const int l = k >> 7, dd = k & 127; d += bf2f(src[(size_t)(16 * c + l) * 256 + dd]) * bf2f(w1[(size_t)hid * 4096 + k]) + pe[k] * w1f[(size_t)k * 128 + hid]; }
            d = wave_sum(d);
            const float u = 0.7978845608028654f * (d + 0.044715f * d * d * d); const float ge = 0.5f * d * (1.f + tanhf(u));
            acc += ge * bf2f(w2[(size_t)dout * 128 + hid]);
        }
        const float got = x ? bf2f(((const bf16*)(ws + WS_VCMPT))[((size_t)(b * 2 + g) * 128 + dout) * NCP + c]) : bf2f(((const bf16*)(ws + WS_KCMP))[((size_t)(b * 2 + g) * NCP + c) * 128 + dout]);
        dbg_flag(ctl, 4, !(fabsf(acc - got) < 0.03f + 0.03f * fabsf(acc)), lane);
    }
}
__device__ __forceinline__ void dbg_after_p7(unsigned char* ws, unsigned* ctl, int gw, int NGW, int lane) {
    for (int s = gw; s < 8192; s += NGW) {
        const unsigned h = hash_u((unsigned)s * 2654435761u + 31337u); const int row = (int)(h % M), col = (int)(hash_u(h + 9u) % 4096u);
        const float ya = dot_bf((const bf16*)(ws + WS_OA) + (size_t)row * 2048, (const bf16*)(ws + WS_WOA) + (size_t)col * 2048, 2048, lane);
        const float yb = dot_bf((const bf16*)(ws + WS_OB) + (size_t)row * 2048, (const bf16*)(ws + WS_WOB) + (size_t)col * 2048, 2048, lane);
        const float ref = bf2f(((const bf16*)(ws + WS_SGA))[(size_t)row * DM + col]) * ya + bf2f(((const bf16*)(ws + WS_SGB))[(size_t)row * DM + col]) * yb;
        const float got = bf2f(((const bf16*)(ws + WS_XN))[(size_t)row * DM + col]);
        dbg_flag(ctl, 5, !(fabsf(ref - got) < 0.01f + 0.03f * fabsf(ref)), lane);
    }
}

constexpr int RING_BYTES = 131072, MISC_OFF = RING_BYTES, LDS_BYTES = 147456;
struct Args { const void* in[27]; float* out; unsigned char* ws; int ph_lo, ph_hi, qoff, pad; };
enum { I_X = 0, I_P, I_POS, I_FFN1_NORM, I_FFN1_WG, I_FFN1_WU, I_FFN1_WD, I_MIX_NORM, I_W_IN, I_SINKS, I_PE_K, I_CK1, I_CK2, I_PE_V, I_CV1, I_CV2, I_WOA, I_WOB, I_WO,
       I_FFN2_NORM, I_FFN2_WG, I_FFN2_WU, I_FFN2_WD, I_PLE_NORM, I_WPG, I_WPP, I_FINAL_NORM };

__global__ void __launch_bounds__(NWAVES * 64, 2) mk_fwd(Args args) {
    extern __shared__ __attribute__((aligned(16))) unsigned char lds_raw[];
    LAS unsigned char* lds = (LAS unsigned char*)lds_raw;
    volatile LAS unsigned* MISC = (volatile LAS unsigned*)(lds + MISC_OFF);
    const int tid = threadIdx.x, lane = tid & 63, wave = __builtin_amdgcn_readfirstlane(tid >> 6);
    const int G = gridDim.x, bx = blockIdx.x;
    const int vcu = (G % 8 == 0) ? (bx % 8) * (G / 8) + bx / 8 : bx;
    const int gw = vcu * NWAVES + wave, NGW = G * NWAVES;
    unsigned char* ws = args.ws;
    unsigned* ctl = (unsigned*)(ws + WS_CTL);
    float* out = args.out;
    for (int u = tid; u < (LDS_BYTES - MISC_OFF) / 4; u += NWAVES * 64) ((LAS unsigned*)(lds + MISC_OFF))[u] = 0u;
    __syncthreads();
    const int lo = args.ph_lo, hi = args.ph_hi;
    XcdBarrier bar; bar.bar = ctl + CW_BAR; bar.x = 0; bar.st = nullptr;
    if (hi - lo > 1) bar = xcd_barrier_post(ctl + CW_BAR, MISC + 8);
#ifndef PH_MASK
#define PH_MASK 0x7fff
#endif
#define IN(k) (((PH_MASK >> (k)) & 1) && lo <= (k) && (k) < hi)
#define SEAM(k) do { if (IN(k) && IN((k) + 1)) xcd_barrier(bar); } while (0)

    if (IN(0)) {
        if (MK_CHECK && bx == 0 && tid == 0) { ctl[CW_DBG + 64 * 10] = 0xffffffffu; ctl[CW_DBG + 64 * 13] = 0xffffffffu; }
        for (int mi = 0; mi < 14; ++mi) {
            if (mi >= 3 && mi <= 8) continue;
            const float* W; bf16* dst; int K, N, map;
            switch (mi) {
                case 0: W = (const float*)args.in[I_FFN1_WG]; dst = (bf16*)(ws + WS_WFF); K = DM; N = DFF; map = MAP_GATE; break;
                case 1: W = (const float*)args.in[I_FFN1_WU]; dst = (bf16*)(ws + WS_WFF); K = DM; N = DFF; map = MAP_UP; break;
                case 2: W = (const float*)args.in[I_FFN1_WD]; dst = (bf16*)(ws + WS_WFD); K = DFF; N = DM; map = MAP_BLK; break;
                case 3: W = (const float*)args.in[I_W_IN]; dst = (bf16*)(ws + WS_WIN); K = DM; N = DIN; map = MAP_WIN; break;
                case 4: W = (const float*)args.in[I_WOA]; dst = (bf16*)(ws + WS_WOA); K = 2048; N = DM; map = MAP_ID; break;
                case 5: W = (const float*)args.in[I_WOB]; dst = (bf16*)(ws + WS_WOB); K = 2048; N = DM; map = MAP_ID; break;
                case 6: W = (const float*)args.in[I_WO]; dst = (bf16*)(ws + WS_WO); K = DM; N = DM; map = MAP_ID; break;
                case 7: W = (const float*)args.in[I_WPG]; dst = (bf16*)(ws + WS_WPG); K = DM; N = DM; map = MAP_ID; break;
                case 8: W = (const float*)args.in[I_WPP]; dst = (bf16*)(ws + WS_WPP); K = PLE; N = DM; map = MAP_ID; break;
                case 9: W = (const float*)args.in[I_CK1]; dst = (bf16*)(ws + WS_CK1); K = 4096; N = 128; map = MAP_ID; break;
                case 10: W = (const float*)args.in[I_CV1]; dst = (bf16*)(ws + WS_CV1); K = 4096; N = 128; map = MAP_ID; break;
                case 11: W = (const float*)args.in[I_CK2]; dst = (bf16*)(ws + WS_CK2); K = 128; N = 128; map = MAP_ID; break;
                case 12: W = (const float*)args.in[I_CV2]; dst = (bf16*)(ws + WS_CV2); K = 128; N = 128; map = MAP_ID; break;
                default: W = nullptr; dst = nullptr; K = 64; N = 0; map = MAP_ID; break;
            }
            const int ni = items_of(K, N);
            int it = gw;
            for (; it + NGW < ni; it += 2 * NGW) tr_item2(W, K, N, dst, map, it, it + NGW, lane);
            if (it < ni) tr_item(W, K, N, dst, map, it, lane);
        }
        for (int m = gw; m < M; m += NGW) norm_row_bf16((const float*)args.in[I_X] + (size_t)m * DM, (const float*)args.in[I_FFN1_NORM], (bf16*)(ws + WS_XN) + (size_t)m * DM, lane);
        { const f32x4* ps = (const f32x4*)args.in[I_P]; u32x2* pd = (u32x2*)(ws + WS_P16);
          for (int i = gw * 64 + lane; i < M * PLE / 4; i += NGW * 64) { const f32x4 v = ps[i]; u32x2 o; o.x = cvt_pk_bf16(v.x, v.y); o.y = cvt_pk_bf16(v.z, v.w); pd[i] = o; } }
        { const int* pos = (const int*)args.in[I_POS]; f32x2* r64 = (f32x2*)(ws + WS_ROPE64); f32x2* r128 = (f32x2*)(ws + WS_ROPE128);
          for (int i = gw * 64 + lane; i < M * 96; i += NGW * 64) {
              const int m = i / 96, e = i % 96; const int f = e < 32 ? e : e - 32; const double base = e < 32 ? 0.7498942093324558273 : 0.8659643233600653524;
              double inv = 1.0; double bp = base; int ff = f;
#pragma unroll
              for (int bit = 0; bit < 6; ++bit) { if (ff & 1) inv *= bp; bp *= bp; ff >>= 1; }
              float c, s; sincos_d((double)pos[m] * inv, c, s);
              if (e < 32) r64[(size_t)m * 32 + f] = (f32x2){c, s}; else r128[(size_t)m * 64 + f] = (f32x2){c, s}; } }
        if (gw < 64) { const int x = gw >> 5, kc = (gw >> 1) & 15, hh = gw & 1; const float* pe = (const float*)args.in[x ? I_PE_V : I_PE_K]; const float* w1 = (const float*)args.in[x ? I_CV1 : I_CK1];
            const int hid = hh * 64 + lane; float s = 0.f;
            for (int k = kc * 256; k < kc * 256 + 256; ++k) s += pe[k] * w1[(size_t)k * 128 + hid];
            ((float*)(ws + WS_CBP))[(x * 16 + kc) * 128 + hid] = s; }
    }
    SEAM(0);
    if (IN(1)) {
        pg8::Gemm g{(const bf16*)(ws + WS_XN), (const bf16*)(ws + WS_WFF), nullptr, nullptr, DM, 0, 0}; pg8::StaticOrder S; S.init(M, 2 * DFF, G, bx);
        pg8::EpiFF E{(bf16*)(ws + WS_ACT)};
        pg8::gemm_phase<pg8::EpiFF, pg8::StaticOrder>(lds, g, S, E);
        { const int nun = (M / 256) * (2 * DFF / 256), nfull = nun - (nun / G) * G; const bool split = nfull > 0 && nfull < G;
          const int nb = split ? G - nfull : G, rb = split ? bx - nfull : bx;
          if (rb >= 0) { const int ni = items_of(DM, DIN); for (int it = rb * NWAVES + wave; it < ni; it += nb * NWAVES) tr_item((const float*)args.in[I_W_IN], DM, DIN, (bf16*)(ws + WS_WIN), MAP_WIN, it, lane); } }
    }
    SEAM(1);
    if (IN(2)) {
        pg8::Gemm g{(const bf16*)(ws + WS_ACT), (const bf16*)(ws + WS_WFD), nullptr, nullptr, DFF, 1, 1}; pg8::StaticOrder S; S.init(M, DM, G, bx, 2);
        pg8::EpiRes E{(const float*)args.in[I_X], out, 0.5f};
        pg8::gemm_phase<pg8::EpiRes, pg8::StaticOrder>(lds, g, S, E);
    }
    SEAM(2);
    if (IN(3)) {
        if (MK_CHECK) { u32x4* sp = (u32x4*)(ws + WS_SGA); for (size_t i = (size_t)gw * 64 + lane; i < (size_t)2 * M * DM * 2 / 16; i += (size_t)NGW * 64) sp[i] = (u32x4){0x47804780u, 0x47804780u, 0x47804780u, 0x47804780u}; }
        for (int m = gw; m < M; m += NGW) norm_row_bf16(out + (size_t)m * DM, (const float*)args.in[I_MIX_NORM], (bf16*)(ws + WS_XN) + (size_t)m * DM, lane);
    }
    SEAM(3);
    if (IN(4)) {
        pg8::Gemm g{(const bf16*)(ws + WS_XN), (const bf16*)(ws + WS_WIN), nullptr, nullptr, DM, 0, 0}; pg8::StaticOrder S; S.init(M, DIN_S, G, bx);
        pg8::EpiIn E{ws};
        pg8::gemm_phase<pg8::EpiIn, pg8::StaticOrder>(lds, g, S, E);
    }
    SEAM(4);
    if (MK_CHECK && lo == 104) dbg_after_p4(ws, ctl, (const int*)args.in[I_POS], gw, NGW, lane);
    if (IN(5)) {
        for (int task = bx; task < 256; task += G) compress_task(ws, lds, task, wave, lane);
        if (wave >= 4) {
            const int gw4 = vcu * 4 + (wave - 4), NGW4 = G * 4;
            for (int mi = 0; mi < 3; ++mi) {
                const float* W = (const float*)args.in[mi == 0 ? I_FFN2_WG : mi == 1 ? I_FFN2_WU : I_FFN2_WD]; bf16* dst = (bf16*)(ws + (mi == 2 ? WS_WFD : WS_WFF));
                const int K = mi == 2 ? DFF : DM, N = mi == 2 ? DM : DFF, map = mi == 0 ? MAP_GATE : mi == 1 ? MAP_UP : MAP_BLK;
                const int ni = items_of(K, N);
                int it = gw4;
                for (; it + NGW4 < ni; it += 2 * NGW4) tr_item2(W, K, N, dst, map, it, it + NGW4, lane);
                if (it < ni) tr_item(W, K, N, dst, map, it, lane);
            }
            for (int mi = 0; mi < 5; ++mi) {
                const float* W = (const float*)args.in[mi == 0 ? I_WOA : mi == 1 ? I_WOB : mi == 2 ? I_WO : mi == 3 ? I_WPG : I_WPP];
                bf16* dst = (bf16*)(ws + (mi == 0 ? WS_WOA : mi == 1 ? WS_WOB : mi == 2 ? WS_WO : mi == 3 ? WS_WPG : WS_WPP));
                const int K = mi < 2 ? 2048 : mi == 4 ? PLE : DM, N = DM;
                const int ni = items_of(K, N);
                int it = gw4;
                for (; it + NGW4 < ni; it += 2 * NGW4) tr_item2(W, K, N, dst, MAP_ID, it, it + NGW4, lane);
                if (it < ni) tr_item(W, K, N, dst, MAP_ID, it, lane);
            }
        }
        const int xq = bx & 7; unsigned* qh = ctl + CW_Q5 + args.qoff + 64 * xq;
        for (;;) {
            int id = 0; if (lane == 0) id = (int)atomicAdd(qh, 1u); id = __builtin_amdgcn_readfirstlane(id);
            if (id >= 128 + 2048) break;
            if (id < 128) gates_task(ws, xq * 128 + id, lane);
            else { const int k = id - 128; mixer_a_task4(ws, (const float*)args.in[I_SINKS], xq >> 2, xq & 3, 2047 - k, lane); }
        }
    }
    SEAM(5);
    if (IN(6)) {
        const int xq = bx & 7; unsigned* qh = ctl + CW_Q6 + args.qoff + 64 * xq;
        volatile LAS unsigned* gctl = (volatile LAS unsigned*)(lds + GX_CTL);
        unsigned nxt = 0u; if (tid == 0) nxt = atomicAdd(qh, 1u);
        for (;;) {
            if (tid == 0) gctl[1] = nxt;
            LDS_WAIT(); __builtin_amdgcn_s_barrier(); asm volatile("" ::: "memory");
            const int id = __builtin_amdgcn_readfirstlane((int)gctl[1]);
            __builtin_amdgcn_s_barrier(); asm volatile("" ::: "memory");
            if (id >= (G_NGROUP + 1) / 2) break;
            if (tid == 0) nxt = atomicAdd(qh, 1u);
            const int tg = 2 * ((G_NGROUP + 1) / 2 - 1 - id) + (xq & 1);
            if (tg < G_NGROUP) nsa_group_task(ws, lds, xq >> 2, (xq >> 1) & 1, tg, wave, lane, MK_P6CRIP ? (args.qoff ? MK_P6CRIP : 0) : 0);
        }
    }
    SEAM(6);
    if (IN(7)) {
        if (MK_CHECK) dbg_after_p5(ws, ctl, (const float*)args.in[I_SINKS], (const float*)args.in[I_PE_K], (const float*)args.in[I_PE_V], (const float*)args.in[I_CK1], (const float*)args.in[I_CV1], gw, NGW, lane);
        pg8::Gemm g{(const bf16*)(ws + WS_OA), (const bf16*)(ws + WS_WOA), (const bf16*)(ws + WS_OB), (const bf16*)(ws + WS_WOB), 2048, 0, 0}; pg8::PairOrder S; S.init(M, DM, G, bx);
        pg8::EpiMerge E{(const bf16*)(ws + WS_SGA), (const bf16*)(ws + WS_SGB), (bf16*)(ws + WS_XN)};
        pg8::gemm_phase<pg8::EpiMerge, pg8::PairOrder>(lds, g, S, E);
    }
    SEAM(7);
    if (IN(8)) {
        if (MK_CHECK) dbg_after_p7(ws, ctl, gw, NGW, lane);
        pg8::Gemm g{(const bf16*)(ws + WS_XN), (const bf16*)(ws + WS_WO), nullptr, nullptr, DM, 0, 0}; pg8::StaticOrder S; S.init(M, DM, G, bx);
        pg8::EpiRes E{out, out, 1.0f};
        pg8::gemm_phase<pg8::EpiRes, pg8::StaticOrder>(lds, g, S, E);
    }
    SEAM(8);
    if (IN(9)) {
        for (int m = gw; m < M; m += NGW) norm_row_bf16(out + (size_t)m * DM, (const float*)args.in[I_FFN2_NORM], (bf16*)(ws + WS_XN) + (size_t)m * DM, lane);
    }
    SEAM(9);
    if (IN(10)) {
        pg8::Gemm g{(const bf16*)(ws + WS_XN), (const bf16*)(ws + WS_WFF), nullptr, nullptr, DM, 0, 0}; pg8::StaticOrder S; S.init(M, 2 * DFF, G, bx);
        pg8::EpiFF E{(bf16*)(ws + WS_ACT)};
        pg8::gemm_phase<pg8::EpiFF, pg8::StaticOrder>(lds, g, S, E);
        const int nfull = (M / 256) * (2 * DFF / 256) - ((M / 256) * (2 * DFF / 256) / G) * G;
        { const bool split = nfull > 0 && nfull < G; const int G2 = split ? G - nfull : G, c2 = split ? bx - nfull : bx;
          if (c2 >= 0) { pg8::Gemm g2{(const bf16*)(ws + WS_P16), (const bf16*)(ws + WS_WPP), nullptr, nullptr, PLE, 0, 0}; pg8::StaticOrder S2; S2.init(M, DM, G2, c2);
              pg8::EpiF32 E2{(float*)(ws + WS_PP)};
              pg8::gemm_phase<pg8::EpiF32, pg8::StaticOrder>(lds, g2, S2, E2); } }
    }
    SEAM(10);
    if (IN(11)) {
        pg8::Gemm g{(const bf16*)(ws + WS_ACT), (const bf16*)(ws + WS_WFD), nullptr, nullptr, DFF, 1, 1}; pg8::StaticOrder S; S.init(M, DM, G, bx, 2);
        pg8::EpiRes E{out, out, 0.5f};
        pg8::gemm_phase<pg8::EpiRes, pg8::StaticOrder>(lds, g, S, E);
    }
    SEAM(11);
    if (IN(12)) {
        for (int m = gw; m < M; m += NGW) norm_row_bf16(out + (size_t)m * DM, (const float*)args.in[I_PLE_NORM], (bf16*)(ws + WS_XN) + (size_t)m * DM, lane);
    }
    SEAM(12);
    if (IN(13)) {
        pg8::Gemm g{(const bf16*)(ws + WS_XN), (const bf16*)(ws + WS_WPG), nullptr, nullptr, DM, 0, 0}; pg8::StaticOrder S; S.init(M, DM, G, bx);
        pg8::EpiPle E{(const float*)(ws + WS_PP), out};
        pg8::gemm_phase<pg8::EpiPle, pg8::StaticOrder>(lds, g, S, E);
    }
    SEAM(13);
    if (IN(14)) {
        for (int m = gw; m < M; m += NGW) norm_row_f32_inplace(out + (size_t)m * DM, (const float*)args.in[I_FINAL_NORM], lane);
#if MK_PERMCHK
        if (bx == 0 && tid == 0) { const unsigned f = __hip_atomic_load(ctl + CW_DBG + 64 * 20, __ATOMIC_RELAXED, __HIP_MEMORY_SCOPE_AGENT); VM_WAIT(); if (f) out[0] = 5000.f; }
#endif
        if (MK_CHECK && bx == 0 && tid == 0) { const unsigned pa = __hip_atomic_load(ctl + CW_DBG + 64 * 10, __ATOMIC_RELAXED, __HIP_MEMORY_SCOPE_AGENT), po = __hip_atomic_load(ctl + CW_DBG + 64 * 11, __ATOMIC_RELAXED, __HIP_MEMORY_SCOPE_AGENT); VM_WAIT(); (void)pa; (void)po; const unsigned ha = __hip_atomic_load(ctl + CW_DBG + 64 * 13, __ATOMIC_RELAXED, __HIP_MEMORY_SCOPE_AGENT), ho = __hip_atomic_load(ctl + CW_DBG + 64 * 14, __ATOMIC_RELAXED, __HIP_MEMORY_SCOPE_AGENT); (void)ho; (void)ha; const unsigned bad = __hip_atomic_load(ctl + CW_DBG + 64 * 7, __ATOMIC_RELAXED, __HIP_MEMORY_SCOPE_AGENT); out[0] = 1000.f * (1.f + 63.f * (float)bad / 8192.f); }
    }
#undef IN
#undef SEAM
}

extern "C" void kernel_launch(void* const* d_in, const int* in_sizes, int n_in, void* d_out, int out_size, void* d_ws, size_t ws_size, hipStream_t stream) {
    static int grid = 0;
    if (grid == 0) {
        if (n_in != 27 || out_size != M * DM || ws_size < WS_END) { fprintf(stderr, "kernel_launch: unexpected shapes (n_in %d, out %d, ws %zu, need %zu); nothing launched\n", n_in, out_size, ws_size, (size_t)WS_END); grid = -1; return; }
        int dev = 0, cus = 0, per_cu = 0;
        if (hipGetDevice(&dev) != hipSuccess || hipDeviceGetAttribute(&cus, hipDeviceAttributeMultiprocessorCount, dev) != hipSuccess) { grid = -1; return; }
        if (hipFuncSetAttribute((const void*)mk_fwd, hipFuncAttributeMaxDynamicSharedMemorySize, LDS_BYTES) != hipSuccess) { fprintf(stderr, "kernel_launch: hipFuncSetAttribute failed\n"); grid = -1; return; }
        if (hipOccupancyMaxActiveBlocksPerMultiprocessor(&per_cu, (const void*)mk_fwd, NWAVES * 64, LDS_BYTES) != hipSuccess || per_cu < 1) fprintf(stderr, "kernel_launch: occupancy query reports %d blocks per CU\n", per_cu);
        (void)hipGetLastError();
        grid = cus;
    }
    if (grid < 0) return;
    if (hipMemsetAsync((char*)d_ws + WS_CTL, 0, CTL_BYTES, stream) != hipSuccess) return;
    Args a{};
    for (int i = 0; i < 27; ++i) a.in[i] = d_in[i];
    a.out = (float*)d_out; a.ws = (unsigned char*)d_ws;
#if MK_ONE_LAUNCH
    a.ph_lo = 0; a.ph_hi = NPHASE;
    hipLaunchKernelGGL(mk_fwd, dim3(grid), dim3(NWAVES * 64), LDS_BYTES, stream, a);
#else
    for (int p = 0; p < NPHASE; ++p) { a.ph_lo = p; a.ph_hi = p + 1; a.qoff = 0; hipLaunchKernelGGL(mk_fwd, dim3(grid), dim3(NWAVES * 64), LDS_BYTES, stream, a);
        if ((MK_DUP >> p) & 1) { a.qoff = 2048; hipLaunchKernelGGL(mk_fwd, dim3(grid), dim3(NWAVES * 64), LDS_BYTES, stream, a); a.qoff = 0; }
        if (MK_CHECK && p == 4) { a.ph_lo = 104; a.ph_hi = 105; hipLaunchKernelGGL(mk_fwd, dim3(grid), dim3(NWAVES * 64), LDS_BYTES, stream, a); } }
#endif
}
```
